# Optimizing an MI355X kernel written in HIP

```python
import math
import jax, jax.numpy as jnp
from jax import lax
import numpy as np

D_MODEL = 2048
BATCH = 2
SEQ = 4096
DEPTH = 4

MIX_WIDTH = D_MODEL // 2
N_BRANCHES = 3
EPS = 1e-6
CHUNK = 128
GM_WIDTH = MIX_WIDTH
GM_GROUP_CH = 128
GM_GROUPS = GM_WIDTH // GM_GROUP_CH
S5_WIDTH = MIX_WIDTH
S5_GROUP_CH = 16
S5_GROUPS = S5_WIDTH // S5_GROUP_CH
S5_STATE = 64
DT_MIN = 1e-3
DT_MAX = 1e-1
SB_WIDTH = MIX_WIDTH
SB_HEAD_DIM = 128
SB_HEADS = SB_WIDTH // SB_HEAD_DIM
SB_BLOCK = 128
PROJ_COLS = 2 * GM_WIDTH + S5_WIDTH + 3 * SB_WIDTH + N_BRANCHES * D_MODEL
D_FF = 4 * D_MODEL

kernel_name = "hybrid_gated_gmlp_s5_stickbreak"


def rmsnorm(x, g):
    xf = x.astype(jnp.float32)
    y = xf * lax.rsqrt(jnp.mean(xf * xf, axis=-1, keepdims=True) + EPS)
    return (y * g.astype(jnp.float32)).astype(x.dtype)


def gmlp_mixer(uv, norm_g, w_s, b_s):
    bsz, seq, _ = uv.shape
    z = jax.nn.gelu(uv)
    u, v = jnp.split(z, 2, axis=-1)
    v = rmsnorm(v, norm_g)
    v = v.reshape(bsz, seq // CHUNK, CHUNK, GM_GROUPS, GM_GROUP_CH)
    w = jnp.tril(w_s)
    mixed = jnp.einsum('gts,bcsgh->bctgh', w, v) + jnp.transpose(b_s)[None, None, :, :, None]
    return u * mixed.reshape(bsz, seq, GM_WIDTH)


def s5_mixer(xin, lam_re, lam_im, log_dt, b_re, b_im, c_re, c_im, d, w_glu, b_glu):
    f32 = jnp.float32
    bsz, seq, _ = xin.shape
    u = xin.astype(f32).reshape(bsz, seq, S5_GROUPS, S5_GROUP_CH)
    lam_re = lam_re.astype(f32)
    lam_im = lam_im.astype(f32)
    b_re = b_re.astype(f32)
    b_im = b_im.astype(f32)
    dt = jnp.exp(log_dt.astype(f32))[:, None]
    mag = jnp.exp(lam_re * dt)
    ab_re = mag * jnp.cos(lam_im * dt)
    ab_im = mag * jnp.sin(lam_im * dt)
    den = lam_re * lam_re + lam_im * lam_im
    n_re = ab_re - 1.0
    n_im = ab_im
    k_re = (n_re * lam_re + n_im * lam_im) / den
    k_im = (n_im * lam_re - n_re * lam_im) / den
    bb_re = k_re[..., None] * b_re - k_im[..., None] * b_im
    bb_im = k_re[..., None] * b_im + k_im[..., None] * b_re
    bu_re = jnp.einsum('blgh,gph->blgp', u, bb_re)
    bu_im = jnp.einsum('blgh,gph->blgp', u, bb_im)
    a_re = jnp.broadcast_to(ab_re, bu_re.shape)
    a_im = jnp.broadcast_to(ab_im, bu_im.shape)

    def combine(e_i, e_j):
        ar_i, ai_i, br_i, bi_i = e_i
        ar_j, ai_j, br_j, bi_j = e_j
        return (ar_j * ar_i - ai_j * ai_i,
                ar_j * ai_i + ai_j * ar_i,
                ar_j * br_i - ai_j * bi_i + br_j,
                ar_j * bi_i + ai_j * br_i + bi_j)

    _, _, s_re, s_im = lax.associative_scan(combine, (a_re, a_im, bu_re, bu_im), axis=1)
    y = (jnp.einsum('blgp,ghp->blgh', s_re, c_re.astype(f32))
         - jnp.einsum('blgp,ghp->blgh', s_im, c_im.astype(f32)))
    y = y.reshape(bsz, seq, S5_WIDTH) + d.astype(f32) * xin.astype(f32)
    g = jax.nn.gelu(y)
    out = g * jax.nn.sigmoid(g @ w_glu.astype(f32) + b_glu.astype(f32))
    return out.astype(xin.dtype)


def stick_breaking_attention(q, k, v):
    f32 = jnp.float32
    seq = q.shape[2]
    scale = SB_HEAD_DIM ** -0.5
    outs = []
    for blk in range(seq // SB_BLOCK):
        t0 = blk * SB_BLOCK
        t1 = t0 + SB_BLOCK
        qb = q[:, :, t0:t1].astype(f32)
        kb = k[:, :, :t1].astype(f32)
        vb = v[:, :, :t1].astype(f32)
        z = jnp.einsum('bhtd,bhsd->bhts', qb, kb) * scale
        mask = jnp.arange(t1)[None, :] < jnp.arange(t0, t1)[:, None]
        log_1m = jnp.where(mask, jax.nn.log_sigmoid(-z), 0.0)
        after = lax.cumsum(log_1m, axis=3, reverse=True) - log_1m
        w = jnp.where(mask, jnp.exp(jax.nn.log_sigmoid(z) + after), 0.0)
        outs.append(jnp.einsum('bhts,bhsd->bhtd', w, vb))
    return jnp.concatenate(outs, axis=2).astype(q.dtype)


def setup_inputs(seed: int = 0) -> dict:
    key = jax.random.key(seed)
    ks = jax.random.split(key, 32)

    def nrm(k, shape, scale):
        return jax.random.normal(k, shape, jnp.float32) * scale

    x = nrm(ks[0], (BATCH, SEQ, D_MODEL), 1.0)
    norm1_g = 1.0 + nrm(ks[1], (DEPTH, D_MODEL), 0.05)
    w_in = nrm(ks[2], (DEPTH, D_MODEL, PROJ_COLS), D_MODEL ** -0.5)
    b_gate = nrm(ks[3], (DEPTH, N_BRANCHES, D_MODEL), 0.1)
    gm_norm_g = 1.0 + nrm(ks[4], (DEPTH, GM_WIDTH), 0.05)
    gm_w_s = nrm(ks[5], (DEPTH, GM_GROUPS, CHUNK, CHUNK), CHUNK ** -0.5)
    gm_b_s = 1.0 + nrm(ks[6], (DEPTH, GM_GROUPS, CHUNK), 0.1)
    s5_lambda_re = -0.5 + nrm(ks[7], (DEPTH, S5_GROUPS, S5_STATE), 0.01)
    s5_lambda_im = (math.pi * jnp.arange(S5_STATE, dtype=jnp.float32))[None, None, :] \
        + nrm(ks[8], (DEPTH, S5_GROUPS, S5_STATE), 0.01)
    s5_log_dt = jax.random.uniform(ks[9], (DEPTH, S5_GROUPS), jnp.float32,
                                   math.log(DT_MIN), math.log(DT_MAX))
    s5_b_re = nrm(ks[10], (DEPTH, S5_GROUPS, S5_STATE, S5_GROUP_CH), (2 * S5_GROUP_CH) ** -0.5)
    s5_b_im = nrm(ks[11], (DEPTH, S5_GROUPS, S5_STATE, S5_GROUP_CH), (2 * S5_GROUP_CH) ** -0.5)
    s5_c_re = nrm(ks[12], (DEPTH, S5_GROUPS, S5_GROUP_CH, S5_STATE), (2 * S5_STATE) ** -0.5)
    s5_c_im = nrm(ks[13], (DEPTH, S5_GROUPS, S5_GROUP_CH, S5_STATE), (2 * S5_STATE) ** -0.5)
    s5_d = nrm(ks[14], (DEPTH, S5_WIDTH), 1.0)
    s5_w_glu = nrm(ks[15], (DEPTH, S5_WIDTH, S5_WIDTH), S5_WIDTH ** -0.5)
    s5_b_glu = nrm(ks[16], (DEPTH, S5_WIDTH), 0.02)
    w_branch = nrm(ks[17], (DEPTH, N_BRANCHES, MIX_WIDTH, D_MODEL), MIX_WIDTH ** -0.5)
    w_out = nrm(ks[18], (DEPTH, D_MODEL, D_MODEL), D_MODEL ** -0.5)
    norm2_g = 1.0 + nrm(ks[19], (DEPTH, D_MODEL), 0.05)
    w_mlp_in = nrm(ks[20], (DEPTH, D_MODEL, D_FF), D_MODEL ** -0.5)
    w_mlp_out = nrm(ks[21], (DEPTH, D_FF, D_MODEL), D_FF ** -0.5)
    final_g = 1.0 + nrm(ks[22], (D_MODEL,), 0.05)
    return {"x": x, "norm1_g": norm1_g, "w_in": w_in, "b_gate": b_gate,
            "gm_norm_g": gm_norm_g, "gm_w_s": gm_w_s, "gm_b_s": gm_b_s,
            "s5_lambda_re": s5_lambda_re, "s5_lambda_im": s5_lambda_im, "s5_log_dt": s5_log_dt,
            "s5_b_re": s5_b_re, "s5_b_im": s5_b_im, "s5_c_re": s5_c_re, "s5_c_im": s5_c_im,
            "s5_d": s5_d, "s5_w_glu": s5_w_glu, "s5_b_glu": s5_b_glu,
            "w_branch": w_branch, "w_out": w_out, "norm2_g": norm2_g,
            "w_mlp_in": w_mlp_in, "w_mlp_out": w_mlp_out, "final_g": final_g}


def reference(x, norm1_g, w_in, b_gate, gm_norm_g, gm_w_s, gm_b_s,
              s5_lambda_re, s5_lambda_im, s5_log_dt, s5_b_re, s5_b_im, s5_c_re, s5_c_im,
              s5_d, s5_w_glu, s5_b_glu, w_branch, w_out, norm2_g,
              w_mlp_in, w_mlp_out, final_g):
    bsz, seq, _ = x.shape
    o_a = 2 * GM_WIDTH
    o_b = o_a + S5_WIDTH
    o_c = o_b + 3 * SB_WIDTH
    for l in range(DEPTH):
        h = rmsnorm(x, norm1_g[l])
        proj = h @ w_in[l]
        uv = proj[..., :o_a]
        s5_in = proj[..., o_a:o_b]
        qkv = proj[..., o_b:o_c].reshape(bsz, seq, 3, SB_HEADS, SB_HEAD_DIM)
        qkv = jnp.transpose(qkv, (2, 0, 3, 1, 4))
        gates = jax.nn.sigmoid(proj[..., o_c:].reshape(bsz, seq, N_BRANCHES, D_MODEL) + b_gate[l])

        y_a = gmlp_mixer(uv, gm_norm_g[l], gm_w_s[l], gm_b_s[l])
        y_b = s5_mixer(s5_in, s5_lambda_re[l], s5_lambda_im[l], s5_log_dt[l],
                       s5_b_re[l], s5_b_im[l], s5_c_re[l], s5_c_im[l],
                       s5_d[l], s5_w_glu[l], s5_b_glu[l])
        y_c = stick_breaking_attention(qkv[0], qkv[1], qkv[2])
        y_c = jnp.transpose(y_c, (0, 2, 1, 3)).reshape(bsz, seq, SB_WIDTH)

        ys = jnp.stack([y_a, y_b, y_c], axis=2)
        br = jnp.einsum('blnw,nwd->blnd', ys, w_branch[l])
        merged = jnp.sum(gates * br, axis=2)
        x = x + merged @ w_out[l]
        h2 = rmsnorm(x, norm2_g[l])
        x = x + jnp.square(jax.nn.relu(h2 @ w_mlp_in[l])) @ w_mlp_out[l]
    return rmsnorm(x, final_g)
```

```cpp
#include <hip/hip_runtime.h>
#include <stdint.h>
#include <stdio.h>

typedef unsigned short bf16;
typedef short bf16x8 __attribute__((ext_vector_type(8)));
typedef float f32x4 __attribute__((ext_vector_type(4)));
typedef unsigned u32x4 __attribute__((ext_vector_type(4)));

constexpr int D = 2048, BATCH = 2, SEQ = 4096, DEPTH = 4, M = BATCH * SEQ;
constexpr int MW = 1024, PC = 12288, DFF = 8192;
constexpr int OFF_U = 0, OFF_V = 1024, OFF_S5 = 2048, OFF_Q = 3072, OFF_K = 4096, OFF_VV = 5120, OFF_G = 6144;
constexpr int YSW = 3072;
constexpr float EPS = 1e-6f;

constexpr size_t MiB = 1u << 20;
constexpr size_t WS_CTL = 0;
constexpr size_t WL_IN = 0, WL_GLU = 48 * MiB, WL_BR = 50 * MiB, WL_OUT = 62 * MiB, WL_MI = 70 * MiB, WL_MO = 102 * MiB, WL_SIZE = 134 * MiB;
constexpr size_t WS_W = 1 * MiB;
constexpr size_t WS_X = WS_W + DEPTH * WL_SIZE;
constexpr size_t WS_H = WS_X + 64 * MiB;
constexpr size_t WS_PROJ = WS_H + 32 * MiB;
constexpr size_t WS_G = WS_PROJ + 192 * MiB;
constexpr size_t WS_YS = WS_G + 16 * MiB;
constexpr size_t WS_MERGED = WS_YS + 48 * MiB;
constexpr size_t WS_HID = WS_MERGED + 32 * MiB;
constexpr size_t WS_VRS = WS_HID + 128 * MiB;
constexpr size_t WS_SALL = WS_VRS + 1 * MiB;
constexpr size_t WS_END = WS_SALL + 256 * MiB;

__device__ __forceinline__ float bf2f(bf16 v) { return __uint_as_float(((unsigned)v) << 16); }
__device__ __forceinline__ bf16 f2bf(float f) { unsigned u = __float_as_uint(f); u += 0x7fffu + ((u >> 16) & 1u); return (bf16)(u >> 16); }
__device__ __forceinline__ unsigned pk2(float lo, float hi) { return (unsigned)f2bf(lo) | ((unsigned)f2bf(hi) << 16); }
__device__ __forceinline__ float gelu_t(float x) { const float u = 0.7978845608028654f * (x + 0.044715f * x * x * x); return x / (1.f + __expf(-2.f * u)); }
__device__ __forceinline__ float sigmoid_f(float x) { return 1.f / (1.f + __expf(-x)); }
__device__ __forceinline__ float softplus_f(float z) { return fmaxf(z, 0.f) + __logf(1.f + __expf(-fabsf(z))); }
__device__ __forceinline__ float wave_sum(float v) {
#pragma unroll
    for (int o = 1; o < 64; o <<= 1) v += __shfl_xor(v, o);
    return v;
}

__device__ __forceinline__ void transpose_tile(const float* W, int N, bf16* WT, int ldo, int koff, float* scr  , int k0, int n0, int lane) {
#pragma unroll 8
    for (int kk = 0; kk < 64; ++kk) scr[kk * 65 + lane] = W[(size_t)(k0 + kk) * N + n0 + lane];
    asm volatile("s_waitcnt lgkmcnt(0)" ::: "memory");
    const int c = lane & 7;
#pragma unroll
    for (int j = 0; j < 8; ++j) {
        const int n = (lane >> 3) + 8 * j; const float* s = scr + (8 * c) * 65 + n;
        u32x4 o; o.x = pk2(s[0], s[65]); o.y = pk2(s[2 * 65], s[3 * 65]); o.z = pk2(s[4 * 65], s[5 * 65]); o.w = pk2(s[6 * 65], s[7 * 65]);
        *(u32x4*)(WT + (size_t)(n0 + n) * ldo + koff + k0 + 8 * c) = o;
    }
    asm volatile("s_waitcnt lgkmcnt(0)" ::: "memory");
}
__global__ __launch_bounds__(256) void k_transpose(const float* W, int K, int N, bf16* WT, int ldo, int koff) {
    __shared__ float scr[4][64 * 65];
    const int wave = threadIdx.x >> 6, lane = threadIdx.x & 63;
    const int ntn = N / 64, nt = (K / 64) * ntn;
    for (int it = blockIdx.x * 4 + wave; it < nt; it += gridDim.x * 4) transpose_tile(W, N, WT, ldo, koff, scr[wave], (it / ntn) * 64, (it % ntn) * 64, lane);
}

__global__ __launch_bounds__(256) void k_rmsnorm_bf16(const float* x, const float* g, bf16* out) {
    const int wave = threadIdx.x >> 6, lane = threadIdx.x & 63;
    for (int row = blockIdx.x * 4 + wave; row < M; row += gridDim.x * 4) {
        const f32x4* xr = (const f32x4*)(x + (size_t)row * D) + lane; f32x4 v[8]; float s = 0.f;
#pragma unroll
        for (int j = 0; j < 8; ++j) { v[j] = xr[64 * j]; s += (v[j].x * v[j].x + v[j].y * v[j].y) + (v[j].z * v[j].z + v[j].w * v[j].w); }
        const float rstd = rsqrtf(wave_sum(s) * (1.f / D) + EPS);
        const f32x4* gr = (const f32x4*)g + lane; uint2* o = (uint2*)(out + (size_t)row * D) + lane;
#pragma unroll
        for (int j = 0; j < 8; ++j) { const f32x4 gg = gr[64 * j]; uint2 w; w.x = pk2(v[j].x * rstd * gg.x, v[j].y * rstd * gg.y); w.y = pk2(v[j].z * rstd * gg.z, v[j].w * rstd * gg.w); o[64 * j] = w; }
    }
}
__global__ __launch_bounds__(256) void k_rmsnorm_f32(const float* x, const float* g, float* out) {
    const int wave = threadIdx.x >> 6, lane = threadIdx.x & 63;
    for (int row = blockIdx.x * 4 + wave; row < M; row += gridDim.x * 4) {
        const f32x4* xr = (const f32x4*)(x + (size_t)row * D) + lane; f32x4 v[8]; float s = 0.f;
#pragma unroll
        for (int j = 0; j < 8; ++j) { v[j] = xr[64 * j]; s += (v[j].x * v[j].x + v[j].y * v[j].y) + (v[j].z * v[j].z + v[j].w * v[j].w); }
        const float rstd = rsqrtf(wave_sum(s) * (1.f / D) + EPS);
        const f32x4* gr = (const f32x4*)g + lane; f32x4* o = (f32x4*)(out + (size_t)row * D) + lane;
#pragma unroll
        for (int j = 0; j < 8; ++j) { const f32x4 gg = gr[64 * j]; o[64 * j] = (f32x4){v[j].x * rstd * gg.x, v[j].y * rstd * gg.y, v[j].z * rstd * gg.z, v[j].w * rstd * gg.w}; }
    }
}

template <class Epi> __global__ __launch_bounds__(256) void k_ogemm(const bf16* A, const bf16* Bt, int lda, int ldb, int K, int pad_, Epi epi) {
    const int wave = threadIdx.x >> 6, lane = threadIdx.x & 63, fr = lane & 15, fq = lane >> 4;
    const int m0 = blockIdx.y * 128 + (wave >> 1) * 64, n0 = blockIdx.x * 128 + (wave & 1) * 64;
    f32x4 acc[4][4];
#pragma unroll
    for (int i = 0; i < 4; ++i)
#pragma unroll
        for (int j = 0; j < 4; ++j) acc[i][j] = (f32x4){0.f, 0.f, 0.f, 0.f};
    const bf16* ap = A + (size_t)(m0 + fr) * lda + 8 * fq; const bf16* bp = Bt + (size_t)(n0 + fr) * ldb + 8 * fq;
    for (int k = 0; k < K; k += 32) {
        bf16x8 a[4], b[4];
#pragma unroll
        for (int i = 0; i < 4; ++i) { a[i] = *(const bf16x8*)(ap + (size_t)(16 * i) * lda + k); b[i] = *(const bf16x8*)(bp + (size_t)(16 * i) * ldb + k); }
#pragma unroll
        for (int i = 0; i < 4; ++i)
#pragma unroll
            for (int j = 0; j < 4; ++j) acc[i][j] = __builtin_amdgcn_mfma_f32_16x16x32_bf16(a[i], b[j], acc[i][j], 0, 0, 0);
    }
#pragma unroll
    for (int i = 0; i < 4; ++i)
#pragma unroll
        for (int j = 0; j < 4; ++j)
#pragma unroll
            for (int jj = 0; jj < 4; ++jj) epi(m0 + 16 * i + 4 * fq + jj, n0 + 16 * j + fr, acc[i][j][jj]);
}
struct OEpiProj { bf16* P; const float* bg;
    __device__ __forceinline__ void operator()(int r, int c, float v) const {
        float o; if (c < OFF_S5) o = gelu_t(v); else if (c < OFF_G) o = v; else o = fmaxf(sigmoid_f(v + bg[c - OFF_G]), 1e-30f);
        P[(size_t)r * PC + c] = f2bf(o); } };
struct OEpiGlu { const bf16* G; const float* b; bf16* YS;
    __device__ __forceinline__ void operator()(int r, int c, float v) const { const float g = bf2f(G[(size_t)r * MW + c]); YS[(size_t)r * YSW + MW + c] = f2bf(g * sigmoid_f(v + b[c])); } };
struct OEpiBranch { const bf16* P; float* T; bf16* Mg; int n; int pad;
    __device__ __forceinline__ void operator()(int r, int c, float v) const {
        const float t = bf2f(P[(size_t)r * PC + OFF_G + n * D + c]) * v; const size_t i = (size_t)r * D + c;
        if (n == 0) T[i] = t; else if (n == 1) T[i] += t; else Mg[i] = f2bf(T[i] + t); } };
struct OEpiRes { const float* base; float* X;
    __device__ __forceinline__ void operator()(int r, int c, float v) const { const size_t i = (size_t)r * D + c; X[i] = base[i] + v; } };
struct OEpiRelu2 { bf16* Hd;
    __device__ __forceinline__ void operator()(int r, int c, float v) const { const float t = fmaxf(v, 0.f); Hd[(size_t)r * DFF + c] = f2bf(t * t); } };

__global__ __launch_bounds__(256) void k_vrstd(const bf16* P, float* vrs) {
    const int wave = threadIdx.x >> 6, lane = threadIdx.x & 63;
    for (int row = blockIdx.x * 4 + wave; row < M; row += gridDim.x * 4) {
        const bf16* v = P + (size_t)row * PC + OFF_V; float s = 0.f;
        for (int j = lane; j < MW; j += 64) { const float t = bf2f(v[j]); s += t * t; }
        s = wave_sum(s); if (lane == 0) vrs[row] = rsqrtf(s * (1.f / MW) + EPS);
    }
}
__global__ __launch_bounds__(256) void k_ogmlp(const bf16* P, const float* vrs, const float* gng, const float* ws, const float* bs, bf16* YS) {
    const int c = blockIdx.x >> 3, g = blockIdx.x & 7; const int row0 = c * 128;
    for (int idx = threadIdx.x; idx < 128 * 128; idx += 256) {
        const int t = idx >> 7, h = idx & 127, ch = g * 128 + h; float s = 0.f;
        for (int sidx = 0; sidx <= t; ++sidx) s += ws[(g * 128 + t) * 128 + sidx] * vrs[row0 + sidx] * bf2f(P[(size_t)(row0 + sidx) * PC + OFF_V + ch]);
        const float mixed = gng[ch] * s + bs[g * 128 + t];
        const float u = bf2f(P[(size_t)(row0 + t) * PC + OFF_U + ch]);
        YS[(size_t)(row0 + t) * YSW + ch] = f2bf(u * mixed);
    }
}

__global__ __launch_bounds__(64) void k_os5_scan(const bf16* P, const float* lre, const float* lim, const float* ldt, const float* bre, const float* bim, float2* S) {
    const int b = blockIdx.x >> 6, g = blockIdx.x & 63, p = threadIdx.x;
    const float dt = expf(ldt[g]); const float lr = lre[g * 64 + p], li = lim[g * 64 + p];
    const float mag = expf(lr * dt); float sn, cs; sincosf(li * dt, &sn, &cs);
    const float ar = mag * cs, ai = mag * sn; const float den = lr * lr + li * li; const float nr = ar - 1.f, ni = ai;
    const float kr = (nr * lr + ni * li) / den, ki = (ni * lr - nr * li) / den;
    float Br[16], Bi[16];
#pragma unroll
    for (int h = 0; h < 16; ++h) { const float x = bre[(g * 64 + p) * 16 + h], y = bim[(g * 64 + p) * 16 + h]; Br[h] = kr * x - ki * y; Bi[h] = kr * y + ki * x; }
    float sr = 0.f, si = 0.f;
    for (int t = 0; t < SEQ; ++t) {
        const bf16* u = P + (size_t)(b * SEQ + t) * PC + OFF_S5 + g * 16;
        const u32x4 u0 = *(const u32x4*)u, u1 = *(const u32x4*)(u + 8); const unsigned uw[8] = {u0.x, u0.y, u0.z, u0.w, u1.x, u1.y, u1.z, u1.w};
        float xr = 0.f, xi = 0.f;
#pragma unroll
        for (int h = 0; h < 8; ++h) { const float a = __uint_as_float(uw[h] << 16), c = __uint_as_float(uw[h] & 0xffff0000u); xr += Br[2 * h] * a + Br[2 * h + 1] * c; xi += Bi[2 * h] * a + Bi[2 * h + 1] * c; }
        const float nsr = ar * sr - ai * si + xr, nsi = ar * si + ai * sr + xi; sr = nsr; si = nsi;
        S[((size_t)(b * SEQ + t) * 64 + g) * 64 + p] = make_float2(sr, si);
    }
}
__global__ __launch_bounds__(256) void k_os5_out(const bf16* P, const float2* S, const float* cre, const float* cim, const float* dd, bf16* G) {
    const size_t idx = (size_t)blockIdx.x * 256 + threadIdx.x;
    const int row = (int)(idx >> 10), ch = (int)(idx & 1023), g = ch >> 4, h = ch & 15;
    const float2* s = S + ((size_t)row * 64 + g) * 64; const float* cr = cre + (g * 16 + h) * 64; const float* ci = cim + (g * 16 + h) * 64; float y = 0.f;
    for (int p = 0; p < 64; ++p) { const float2 v = s[p]; y += v.x * cr[p] - v.y * ci[p]; }
    y += dd[ch] * bf2f(P[(size_t)row * PC + OFF_S5 + ch]);
    G[(size_t)row * MW + ch] = f2bf(gelu_t(y));
}

__global__ __launch_bounds__(64) void k_oattn(const bf16* P, bf16* YS) {
    __shared__ float qs[128]; __shared__ float wsh[64];
    const int lane = threadIdx.x; const int qid = blockIdx.x; const int t = qid & 4095, hd = (qid >> 12) & 7, b = qid >> 15;
    const bf16* base = P + (size_t)(b * SEQ) * PC;
    qs[lane] = bf2f(base[(size_t)t * PC + OFF_Q + hd * 128 + lane]); qs[lane + 64] = bf2f(base[(size_t)t * PC + OFF_Q + hd * 128 + 64 + lane]);
    __syncthreads();
    const float scale = 0.08838834764831845f;
    float o0 = 0.f, o1 = 0.f, R = 0.f;
    for (int hi = t - 1; hi >= 0; hi -= 64) {
        const int s = hi - lane; const bool valid = s >= 0; float z = 0.f;
        if (valid) { const bf16* kr = base + (size_t)s * PC + OFF_K + hd * 128;
            for (int d = 0; d < 128; d += 8) { const u32x4 kv = *(const u32x4*)(kr + d); const unsigned kw[4] = {kv.x, kv.y, kv.z, kv.w};
#pragma unroll
                for (int i = 0; i < 4; ++i) z += qs[d + 2 * i] * __uint_as_float(kw[i] << 16) + qs[d + 2 * i + 1] * __uint_as_float(kw[i] & 0xffff0000u); }
            z *= scale; }
        const float L = valid ? -softplus_f(z) : 0.f;
        float Pf = L;
#pragma unroll
        for (int o = 1; o < 64; o <<= 1) { const float v = __shfl_up(Pf, o); if (lane >= o) Pf += v; }
        const float after = R + (Pf - L);
        const float w = valid ? __expf(z + L + after) : 0.f;
        R += __shfl(Pf, 63);
        wsh[lane] = w; __syncthreads();
        const int cnt = hi + 1 < 64 ? hi + 1 : 64;
        for (int j = 0; j < cnt; ++j) { const float wj = wsh[j]; const bf16* vr = base + (size_t)(hi - j) * PC + OFF_VV + hd * 128; o0 += wj * bf2f(vr[lane]); o1 += wj * bf2f(vr[lane + 64]); }
        __syncthreads();
    }
    bf16* o = YS + (size_t)(b * SEQ + t) * YSW + 2 * MW + hd * 128; o[lane] = f2bf(o0); o[lane + 64] = f2bf(o1);
}

extern "C" void kernel_launch(void* const* d_in, const int* in_sizes, int n_in, void* d_out, int out_size, void* d_ws, size_t ws_size, hipStream_t stream) {
    if (n_in != 23 || out_size != M * D || ws_size < WS_END) { fprintf(stderr, "kernel_launch: unexpected shapes (n_in %d out %d ws %zu need %zu)\n", n_in, out_size, ws_size, (size_t)WS_END); return; }
    const float* x = (const float*)d_in[0]; const float* norm1_g = (const float*)d_in[1]; const float* w_in = (const float*)d_in[2]; const float* b_gate = (const float*)d_in[3];
    const float* gm_norm_g = (const float*)d_in[4]; const float* gm_w_s = (const float*)d_in[5]; const float* gm_b_s = (const float*)d_in[6];
    const float* lre = (const float*)d_in[7]; const float* lim = (const float*)d_in[8]; const float* ldt = (const float*)d_in[9];
    const float* bre = (const float*)d_in[10]; const float* bim = (const float*)d_in[11]; const float* cre = (const float*)d_in[12]; const float* cim = (const float*)d_in[13];
    const float* s5d = (const float*)d_in[14]; const float* w_glu = (const float*)d_in[15]; const float* b_glu = (const float*)d_in[16];
    const float* w_branch = (const float*)d_in[17]; const float* w_out = (const float*)d_in[18]; const float* norm2_g = (const float*)d_in[19];
    const float* w_mlp_in = (const float*)d_in[20]; const float* w_mlp_out = (const float*)d_in[21]; const float* final_g = (const float*)d_in[22];
    unsigned char* ws = (unsigned char*)d_ws;
    float* X = (float*)(ws + WS_X); bf16* H = (bf16*)(ws + WS_H); bf16* P = (bf16*)(ws + WS_PROJ); bf16* G = (bf16*)(ws + WS_G); bf16* YS = (bf16*)(ws + WS_YS);
    bf16* MG = (bf16*)(ws + WS_MERGED); bf16* HID = (bf16*)(ws + WS_HID); float* TMP = (float*)(ws + WS_HID); float* VRS = (float*)(ws + WS_VRS); float2* SALL = (float2*)(ws + WS_SALL);
    for (int l = 0; l < DEPTH; ++l) {
        unsigned char* wl = ws + WS_W + (size_t)l * WL_SIZE;
        hipLaunchKernelGGL(k_transpose, dim3(2048), dim3(256), 0, stream, w_in + (size_t)l * D * PC, D, PC, (bf16*)(wl + WL_IN), D, 0);
        hipLaunchKernelGGL(k_transpose, dim3(256), dim3(256), 0, stream, w_glu + (size_t)l * MW * MW, MW, MW, (bf16*)(wl + WL_GLU), MW, 0);
        for (int n = 0; n < 3; ++n) hipLaunchKernelGGL(k_transpose, dim3(512), dim3(256), 0, stream, w_branch + ((size_t)l * 3 + n) * MW * D, MW, D, (bf16*)(wl + WL_BR), 3 * MW, n * MW);
        hipLaunchKernelGGL(k_transpose, dim3(1024), dim3(256), 0, stream, w_out + (size_t)l * D * D, D, D, (bf16*)(wl + WL_OUT), D, 0);
        hipLaunchKernelGGL(k_transpose, dim3(2048), dim3(256), 0, stream, w_mlp_in + (size_t)l * D * DFF, D, DFF, (bf16*)(wl + WL_MI), D, 0);
        hipLaunchKernelGGL(k_transpose, dim3(2048), dim3(256), 0, stream, w_mlp_out + (size_t)l * DFF * D, DFF, D, (bf16*)(wl + WL_MO), DFF, 0);
    }
    for (int l = 0; l < DEPTH; ++l) {
        unsigned char* wl = ws + WS_W + (size_t)l * WL_SIZE;
        const float* xsrc = l == 0 ? x : X;
        hipLaunchKernelGGL(k_rmsnorm_bf16, dim3(2048), dim3(256), 0, stream, xsrc, norm1_g + (size_t)l * D, H);
        hipLaunchKernelGGL(k_ogemm<OEpiProj>, dim3(PC / 128, M / 128), dim3(256), 0, stream, (const bf16*)H, (const bf16*)(wl + WL_IN), D, D, D, 0, OEpiProj{P, b_gate + (size_t)l * 3 * D});
        hipLaunchKernelGGL(k_vrstd, dim3(2048), dim3(256), 0, stream, (const bf16*)P, VRS);
        hipLaunchKernelGGL(k_ogmlp, dim3(64 * 8), dim3(256), 0, stream, (const bf16*)P, (const float*)VRS, gm_norm_g + (size_t)l * MW, gm_w_s + (size_t)l * 8 * 128 * 128, gm_b_s + (size_t)l * 8 * 128, YS);
        hipLaunchKernelGGL(k_os5_scan, dim3(BATCH * 64), dim3(64), 0, stream, (const bf16*)P, lre + (size_t)l * 4096, lim + (size_t)l * 4096, ldt + (size_t)l * 64, bre + (size_t)l * 65536, bim + (size_t)l * 65536, SALL);
        hipLaunchKernelGGL(k_os5_out, dim3(M * MW / 256), dim3(256), 0, stream, (const bf16*)P, (const float2*)SALL, cre + (size_t)l * 65536, cim + (size_t)l * 65536, s5d + (size_t)l * MW, G);
        hipLaunchKernelGGL(k_ogemm<OEpiGlu>, dim3(MW / 128, M / 128), dim3(256), 0, stream, (const bf16*)G, (const bf16*)(wl + WL_GLU), MW, MW, MW, 0, OEpiGlu{G, b_glu + (size_t)l * MW, YS});
        hipLaunchKernelGGL(k_oattn, dim3(BATCH * 8 * SEQ), dim3(64), 0, stream, (const bf16*)P, YS);
        for (int n = 0; n < 3; ++n)
            hipLaunchKernelGGL(k_ogemm<OEpiBranch>, dim3(D / 128, M / 128), dim3(256), 0, stream, (const bf16*)(YS + n * MW), (const bf16*)(wl + WL_BR) + n * MW, YSW, 3 * MW, MW, 0, OEpiBranch{P, TMP, MG, n, 0});
        hipLaunchKernelGGL(k_ogemm<OEpiRes>, dim3(D / 128, M / 128), dim3(256), 0, stream, (const bf16*)MG, (const bf16*)(wl + WL_OUT), D, D, D, 0, OEpiRes{xsrc, X});
        hipLaunchKernelGGL(k_rmsnorm_bf16, dim3(2048), dim3(256), 0, stream, (const float*)X, norm2_g + (size_t)l * D, H);
        hipLaunchKernelGGL(k_ogemm<OEpiRelu2>, dim3(DFF / 128, M / 128), dim3(256), 0, stream, (const bf16*)H, (const bf16*)(wl + WL_MI), D, D, D, 0, OEpiRelu2{HID});
        hipLaunchKernelGGL(k_ogemm<OEpiRes>, dim3(D / 128, M / 128), dim3(256), 0, stream, (const bf16*)HID, (const bf16*)(wl + WL_MO), DFF, DFF, DFF, 0, OEpiRes{X, X});
    }
    hipLaunchKernelGGL(k_rmsnorm_f32, dim3(2048), dim3(256), 0, stream, (const float*)X, final_g, (float*)d_out);
}
```

```cpp
#include <hip/hip_runtime.h>
#include <stdint.h>
#include <stdio.h>

typedef unsigned short bf16;
typedef short bf16x8 __attribute__((ext_vector_type(8)));
typedef float f32x4 __attribute__((ext_vector_type(4)));
typedef float f32x16 __attribute__((ext_vector_type(16)));
typedef unsigned u32x4 __attribute__((ext_vector_type(4)));
typedef unsigned u32x2 __attribute__((ext_vector_type(2)));
typedef float f32x2 __attribute__((ext_vector_type(2)));

constexpr int D = 2048, BATCH = 2, SEQ = 4096, DEPTH = 4, M = BATCH * SEQ;
constexpr int MW = 1024, PC = 12288, DFF = 8192;
constexpr int OFF_U = 0, OFF_V = 1024, OFF_S5 = 2048, OFF_Q = 3072, OFF_K = 4096, OFF_VV = 5120, OFF_G = 6144;
constexpr int YSW = 3072;
constexpr float EPS = 1e-6f;

constexpr size_t MiB = 1u << 20;
constexpr size_t WS_CTL = 0;
constexpr size_t WL_IN = 0, WL_GLU = 48 * MiB, WL_BR = 50 * MiB, WL_OUT = 62 * MiB, WL_MI = 70 * MiB, WL_MO = 102 * MiB;
constexpr size_t WL_WST = 134 * MiB;
constexpr size_t WL_W2 = 138 * MiB;
constexpr size_t WL_A16 = 150 * MiB;
constexpr size_t WL_SIZE = 151 * MiB;
constexpr size_t WS_W = 1 * MiB;
constexpr size_t WS_X = WS_W + DEPTH * WL_SIZE;
constexpr size_t WS_H = WS_X + 64 * MiB;
constexpr size_t WS_PROJ = WS_H + 32 * MiB;
constexpr size_t WS_G = WS_PROJ + 192 * MiB;
constexpr size_t WS_YS = WS_G + 16 * MiB;
constexpr size_t WS_MERGED = WS_YS + 48 * MiB;
constexpr size_t WS_HID = WS_MERGED + 32 * MiB;
constexpr size_t WS_VSQ = WS_HID + 128 * MiB;
constexpr size_t WS_SST = WS_VSQ + 1 * MiB;
constexpr size_t WS_VRS = WS_SST + 8 * MiB;
constexpr size_t WS_SALL = WS_VRS + 1 * MiB;
constexpr size_t WS_END = WS_SALL + 256 * MiB;

__device__ __forceinline__ float bf2f(bf16 v) { return __uint_as_float(((unsigned)v) << 16); }
__device__ __forceinline__ bf16 f2bf(float f) { unsigned u = __float_as_uint(f); u += 0x7fffu + ((u >> 16) & 1u); return (bf16)(u >> 16); }
__device__ __forceinline__ unsigned pk2(float lo, float hi) { return (unsigned)f2bf(lo) | ((unsigned)f2bf(hi) << 16); }
__device__ __forceinline__ float gelu_t(float x) { const float u = 0.7978845608028654f * (x + 0.044715f * x * x * x); return x / (1.f + __expf(-2.f * u)); }
__device__ __forceinline__ float sigmoid_f(float x) { return 1.f / (1.f + __expf(-x)); }
__device__ __forceinline__ float softplus_f(float z) { return fmaxf(z, 0.f) + __logf(1.f + __expf(-fabsf(z))); }
__device__ __forceinline__ float wave_sum(float v) {
#pragma unroll
    for (int o = 1; o < 64; o <<= 1) v += __shfl_xor(v, o);
    return v;
}
__device__ __forceinline__ float bflo(unsigned w) { return __uint_as_float(w << 16); }
__device__ __forceinline__ float bfhi(unsigned w) { return __uint_as_float(w & 0xffff0000u); }
#define MK_MODE 0
#define MK_SUB 7
namespace pg8 {
#define PG8_LAS __attribute__((address_space(3)))
typedef unsigned short bf16_t;
typedef short bf16x8 __attribute__((ext_vector_type(8)));
typedef float f32x4 __attribute__((ext_vector_type(4)));
typedef unsigned u32x4 __attribute__((ext_vector_type(4)));
constexpr int BM = 256, BK = 64, HALF = 128, HTB = HALF * BK * 2  , STAGE_BYTES = 8 * HTB, NXCD = 8, WGM = 8;

__host__ __device__ __forceinline__ int lds_byte(int r, int c) { const int st = (r >> 4) * 2 + (c >> 5), rr = r & 15, cc = c & 31, ob = rr * 64 + cc * 2; return st * 1024 + (ob ^ (((ob >> 9) & 1) << 5)); }
__host__ __device__ __forceinline__ void stage_rc(int b, int& R, int& C) { const int st = b / 1024, sb = b % 1024, swz = sb ^ (((sb >> 9) & 1) << 5); R = (st >> 1) * 16 + swz / 64; C = (st & 1) * 32 + (swz % 64) / 2; }
__host__ __device__ __forceinline__ int perm32(int rho) { const int n = rho >> 4, i = rho & 15; return 8 * (i >> 2) + 4 * n + (i & 3); }

struct Unit { int pm, pn; };
struct Gemm { const bf16_t* A; const bf16_t* Bt; int M, N, K; };

struct StaticOrder {
    int nM, nN, nwg, G, c;
    __host__ __device__ void init(int M, int N, int G_, int c_) { nM = M / BM; nN = N / BM; nwg = nM * nN; G = G_; c = c_; }
    __host__ __device__ bool next(int i, Unit& u) const {
        const long L = (long)i * G + c; if (L >= nwg) return false;
        int wgid = (int)L; { const int q = nwg / NXCD, r = nwg % NXCD, xcd = wgid % NXCD, off = wgid / NXCD; wgid = (xcd < r ? xcd * (q + 1) : r * (q + 1) + (xcd - r) * q) + off; }
        const int nig = WGM * nN, gid = wgid / nig, fm = gid * WGM, gsz = (nM - fm) < WGM ? (nM - fm) : WGM;
        u.pm = fm + ((wgid % nig) % gsz); u.pn = (wgid % nig) / gsz; return true;
    }
    __device__ __forceinline__ void a_ready(const Unit&) const {}
    __device__ __forceinline__ void done(const Unit&) const {}
};
__device__ __forceinline__ unsigned cvt_pk_bf16(float lo, float hi) { unsigned r; asm volatile("v_cvt_pk_bf16_f32 %0, %1, %2" : "=v"(r) : "v"(lo), "v"(hi)); return r; }
__device__ __forceinline__ u32x4 pack8(const f32x4& v0, const f32x4& v1) { u32x4 w; w.x = cvt_pk_bf16(v0[0], v0[1]); w.y = cvt_pk_bf16(v0[2], v0[3]); w.z = cvt_pk_bf16(v1[0], v1[1]); w.w = cvt_pk_bf16(v1[2], v1[3]); return w; }
__device__ __forceinline__ void unpack8(const u32x4& w, f32x4& v0, f32x4& v1) { v0 = (f32x4){bflo(w.x), bfhi(w.x), bflo(w.y), bfhi(w.y)}; v1 = (f32x4){bflo(w.z), bfhi(w.z), bflo(w.w), bfhi(w.w)}; }

struct EpiProj {
    static constexpr bool PERM = true, AFTER_DRAIN = false, RESCALE = false;
    bf16_t* P; const float* bg; float* vsq;
    __device__ __forceinline__ void rescale(f32x4 (&)[2][2][4][2], const Unit&, int, int, int, int, int) const {}
    template <int KIND> __device__ __forceinline__ void run(const f32x4 (&acc)[2][2][4][2], const Unit& u, int wr, int wc, int fr, int fq) const {
        const int row0 = u.pm * BM + wr * 64 + fr, col0 = u.pn * BM + wc * 32 + 8 * fq;
        f32x4 bv[2][2];
        if (KIND == 3) {
#pragma unroll
            for (int bj = 0; bj < 2; ++bj)
#pragma unroll
                for (int n = 0; n < 2; ++n) bv[bj][n] = *(const f32x4*)(bg + (col0 - OFF_G) + bj * HALF + 4 * n);
        }
#pragma unroll
        for (int ai = 0; ai < 2; ++ai)
#pragma unroll
            for (int m = 0; m < 4; ++m) {
                const int row = row0 + ai * HALF + m * 16; bf16_t* rowp = P + (size_t)row * PC + col0; float ss = 0.f;
#pragma unroll
                for (int bj = 0; bj < 2; ++bj) {
                    f32x4 v0 = acc[ai][bj][m][0], v1 = acc[ai][bj][m][1];
                    if (KIND <= 1) {
#pragma unroll
                        for (int j = 0; j < 4; ++j) { v0[j] = gelu_t(v0[j]); v1[j] = gelu_t(v1[j]); }
                        if (KIND == 1) ss += (v0[0] * v0[0] + v0[1] * v0[1]) + (v0[2] * v0[2] + v0[3] * v0[3]) + (v1[0] * v1[0] + v1[1] * v1[1]) + (v1[2] * v1[2] + v1[3] * v1[3]);
                    } else if (KIND == 3) {
                        v0 = v0 + bv[bj][0]; v1 = v1 + bv[bj][1];
#pragma unroll
                        for (int j = 0; j < 4; ++j) { v0[j] = fmaxf(sigmoid_f(v0[j]), 1e-30f); v1[j] = fmaxf(sigmoid_f(v1[j]), 1e-30f); }
                    }
                    *(u32x4*)(rowp + bj * HALF) = pack8(v0, v1);
                }
                if (KIND == 1) { ss += __shfl_xor(ss, 16); ss += __shfl_xor(ss, 32); if (fq == 0) vsq[(size_t)row * 16 + (u.pn - 4) * 4 + wc] = ss; }
            }
    }
    __device__ __forceinline__ void operator()(const f32x4 (&acc)[2][2][4][2], const Unit& u, int wr, int wc, int fr, int fq) const {
        if (u.pn < 4) run<0>(acc, u, wr, wc, fr, fq);
        else if (u.pn < 8) run<1>(acc, u, wr, wc, fr, fq);
        else if (u.pn < 24) run<2>(acc, u, wr, wc, fr, fq);
        else run<3>(acc, u, wr, wc, fr, fq);
    }
};
struct EpiGlu {
    static constexpr bool PERM = true, AFTER_DRAIN = false, RESCALE = false;
    const bf16_t* G; const float* b; bf16_t* YS;
    __device__ __forceinline__ void rescale(f32x4 (&)[2][2][4][2], const Unit&, int, int, int, int, int) const {}
    __device__ __forceinline__ void operator()(const f32x4 (&acc)[2][2][4][2], const Unit& u, int wr, int wc, int fr, int fq) const {
        const int row0 = u.pm * BM + wr * 64 + fr, col0 = u.pn * BM + wc * 32 + 8 * fq;
        f32x4 bv[2][2];
#pragma unroll
        for (int bj = 0; bj < 2; ++bj)
#pragma unroll
            for (int n = 0; n < 2; ++n) bv[bj][n] = *(const f32x4*)(b + col0 + bj * HALF + 4 * n);
#pragma unroll
        for (int ai = 0; ai < 2; ++ai)
#pragma unroll
            for (int m = 0; m < 4; ++m) {
                const int row = row0 + ai * HALF + m * 16;
#pragma unroll
                for (int bj = 0; bj < 2; ++bj) {
                    f32x4 g0, g1; unpack8(*(const u32x4*)(G + (size_t)row * MW + col0 + bj * HALF), g0, g1);
                    f32x4 v0 = acc[ai][bj][m][0] + bv[bj][0], v1 = acc[ai][bj][m][1] + bv[bj][1];
#pragma unroll
                    for (int j = 0; j < 4; ++j) { v0[j] = g0[j] * sigmoid_f(v0[j]); v1[j] = g1[j] * sigmoid_f(v1[j]); }
                    *(u32x4*)(YS + (size_t)row * YSW + MW + col0 + bj * HALF) = pack8(v0, v1);
                }
            }
    }
};
struct EpiBranch {
    static constexpr bool PERM = true, AFTER_DRAIN = false, RESCALE = true;
    const bf16_t* P; bf16_t* Mg;
    __device__ __forceinline__ void rescale(f32x4 (&acc)[2][2][4][2], const Unit& u, int seg, int wr, int wc, int fr, int fq) const {
        const int row0 = u.pm * BM + wr * 64 + fr, col0 = u.pn * BM + wc * 32 + 8 * fq;
#pragma unroll
        for (int ai = 0; ai < 2; ++ai)
#pragma unroll
            for (int mh = 0; mh < 2; ++mh) {
                u32x4 gp[2][2], gn[2][2];
#pragma unroll
                for (int mm = 0; mm < 2; ++mm)
#pragma unroll
                    for (int bj = 0; bj < 2; ++bj) { const bf16_t* q = P + (size_t)(row0 + ai * HALF + (2 * mh + mm) * 16) * PC + OFF_G + (seg - 1) * D + col0 + bj * HALF; gp[mm][bj] = *(const u32x4*)q; gn[mm][bj] = *(const u32x4*)(q + D); }
#pragma unroll
                for (int mm = 0; mm < 2; ++mm)
#pragma unroll
                    for (int bj = 0; bj < 2; ++bj) { const int m = 2 * mh + mm; f32x4 a0, a1, b0, b1; unpack8(gp[mm][bj], a0, a1); unpack8(gn[mm][bj], b0, b1);
#pragma unroll
                        for (int j = 0; j < 4; ++j) { acc[ai][bj][m][0][j] *= a0[j] * __builtin_amdgcn_rcpf(b0[j]); acc[ai][bj][m][1][j] *= a1[j] * __builtin_amdgcn_rcpf(b1[j]); } }
                asm volatile("" ::: "memory");
            }
    }
    __device__ __forceinline__ void operator()(const f32x4 (&acc)[2][2][4][2], const Unit& u, int wr, int wc, int fr, int fq) const {
        const int row0 = u.pm * BM + wr * 64 + fr, col0 = u.pn * BM + wc * 32 + 8 * fq;
#pragma unroll
        for (int ai = 0; ai < 2; ++ai)
#pragma unroll
            for (int m = 0; m < 4; ++m) {
                const int row = row0 + ai * HALF + m * 16;
#pragma unroll
                for (int bj = 0; bj < 2; ++bj) {
                    f32x4 g0, g1; unpack8(*(const u32x4*)(P + (size_t)row * PC + OFF_G + 2 * D + col0 + bj * HALF), g0, g1);
                    *(u32x4*)(Mg + (size_t)row * D + col0 + bj * HALF) = pack8(acc[ai][bj][m][0] * g0, acc[ai][bj][m][1] * g1);
                }
            }
    }
};
struct EpiRes {
    static constexpr bool PERM = false, AFTER_DRAIN = false, RESCALE = false;
    const float* base; float* X;
    __device__ __forceinline__ void rescale(f32x4 (&)[2][2][4][2], const Unit&, int, int, int, int, int) const {}
    __device__ __forceinline__ void operator()(const f32x4 (&acc)[2][2][4][2], const Unit& u, int wr, int wc, int fr, int fq) const {
        const int row0 = u.pm * BM + wr * 64 + fr, col0 = u.pn * BM + wc * 32 + 4 * fq;
#pragma unroll
        for (int ai = 0; ai < 2; ++ai)
#pragma unroll
            for (int m = 0; m < 4; ++m) {
                const size_t off = (size_t)(row0 + ai * HALF + m * 16) * D + col0;
#pragma unroll
                for (int bj = 0; bj < 2; ++bj)
#pragma unroll
                    for (int n = 0; n < 2; ++n) { const size_t o = off + bj * HALF + n * 16; *(f32x4*)(X + o) = *(const f32x4*)(base + o) + acc[ai][bj][m][n]; }
            }
    }
};
struct EpiRelu2 {
    static constexpr bool PERM = true, AFTER_DRAIN = false, RESCALE = false;
    bf16_t* Hd;
    __device__ __forceinline__ void rescale(f32x4 (&)[2][2][4][2], const Unit&, int, int, int, int, int) const {}
    __device__ __forceinline__ void operator()(const f32x4 (&acc)[2][2][4][2], const Unit& u, int wr, int wc, int fr, int fq) const {
        const int row0 = u.pm * BM + wr * 64 + fr, col0 = u.pn * BM + wc * 32 + 8 * fq;
#pragma unroll
        for (int ai = 0; ai < 2; ++ai)
#pragma unroll
            for (int m = 0; m < 4; ++m) {
                bf16_t* rowp = Hd + (size_t)(row0 + ai * HALF + m * 16) * DFF + col0;
#pragma unroll
                for (int bj = 0; bj < 2; ++bj) {
                    f32x4 v0 = acc[ai][bj][m][0], v1 = acc[ai][bj][m][1];
#pragma unroll
                    for (int j = 0; j < 4; ++j) { const float a = fmaxf(v0[j], 0.f), c = fmaxf(v1[j], 0.f); v0[j] = a * a; v1[j] = c * c; }
                    *(u32x4*)(rowp + bj * HALF) = pack8(v0, v1);
                }
            }
    }
};
template <class Epi, class Sched, bool ALIGN_EPI = false, bool SP2 = false>
__device__ __forceinline__ void gemm_phase(PG8_LAS unsigned char* lds, const Gemm g, const Sched& S, const Epi& E, const int tid_in) {
    int tid_l = tid_in; asm volatile("" : "+v"(tid_l));
    const int tid = tid_l, wid = __builtin_amdgcn_readfirstlane(tid >> 6), lane = tid & 63, wr = wid >> 2, wc = wid & 3, fr = lane & 15, fq = lane >> 4;
    const int K = g.K, nt = K / BK;
    unsigned voffA[2], voffB[2];
#pragma unroll
    for (int i = 0; i < 2; ++i) { int R, C; stage_rc(tid * 16 + i * 8192, R, C); const int Rb = Epi::PERM ? ((R & ~31) + perm32(R & 31)) : R;
        voffA[i] = (unsigned)(R * K + C) * 2u; voffB[i] = (unsigned)(Rb * K + C) * 2u; }
    const size_t kstep = (size_t)(BK * 2);
    const size_t hstep = (size_t)HALF * K * 2;
    const size_t tstep = 2 * hstep;
    const unsigned ldsw = (unsigned)wid * 1024u;
    const int aoff = lds_byte(wr * 64 + fr, fq * 8), boff = lds_byte(wc * 32 + fr, fq * 8);
#define PG8_SA(b, h) (((b) * 2 + (h)) * HTB)
#define PG8_SB(b, h) ((4 + (b) * 2 + (h)) * HTB)
#define PG8_STAGE(bufoff, gbase, voff) do { _Pragma("unroll") for (int _i = 0; _i < 2; ++_i) \
        __builtin_amdgcn_global_load_lds((const unsigned*)((const char*)(gbase) + (voff)[_i]), (PG8_LAS unsigned*)(lds + (bufoff) + ldsw + _i * 8192), 16, 0, 0); } while (0)
#define PG8_LDA(dst, b, h) do { _Pragma("unroll") for (int m = 0; m < 4; ++m) _Pragma("unroll") for (int k = 0; k < 2; ++k) dst[m][k] = *(const PG8_LAS bf16x8*)(lds + PG8_SA(b, h) + aoff + m * 2048 + k * 1024); } while (0)
#define PG8_LDB(dst, b, h) do { _Pragma("unroll") for (int n = 0; n < 2; ++n) _Pragma("unroll") for (int k = 0; k < 2; ++k) dst[n][k] = *(const PG8_LAS bf16x8*)(lds + PG8_SB(b, h) + boff + n * 2048 + k * 1024); } while (0)
#define PG8_MMA(ai, bj, At, Bt) do { __builtin_amdgcn_s_setprio(1); _Pragma("unroll") for (int m = 0; m < 4; ++m) _Pragma("unroll") for (int n = 0; n < 2; ++n) _Pragma("unroll") for (int k = 0; k < 2; ++k) \
        acc[ai][bj][m][n] = __builtin_amdgcn_mfma_f32_16x16x32_bf16(Bt[n][k], At[m][k], acc[ai][bj][m][n], 0, 0, 0); __builtin_amdgcn_s_setprio(0); } while (0)
#define PG8_WAIT_V(n) asm volatile("s_waitcnt vmcnt(" #n ")" ::: "memory")
#define PG8_WAIT_L(n) asm volatile("s_waitcnt lgkmcnt(" #n ")" ::: "memory")
#define PG8_BAR __builtin_amdgcn_s_barrier()
#define PG8_SCHED __builtin_amdgcn_sched_barrier(0)
    Unit cur, nxt; int ui = 0;
    if (!S.next(0, cur)) return;
    f32x4 acc[2][2][4][2];
#pragma unroll
    for (int a = 0; a < 2; ++a)
#pragma unroll
        for (int b = 0; b < 2; ++b)
#pragma unroll
            for (int m = 0; m < 4; ++m)
#pragma unroll
                for (int n = 0; n < 2; ++n) acc[a][b][m][n] = (f32x4){0.f, 0.f, 0.f, 0.f};
    bf16x8 At[4][2], B0[2][2], B1[2][2];
    const char* cA = (const char*)g.A + (size_t)cur.pm * tstep; const char* cB = (const char*)g.Bt + (size_t)cur.pn * tstep;
    S.a_ready(cur);
    if constexpr (SP2) {
        PG8_STAGE(PG8_SB(0, 0), cB, voffB); PG8_STAGE(PG8_SB(0, 1), cB + hstep, voffB); PG8_STAGE(PG8_SA(0, 0), cA, voffA); PG8_STAGE(PG8_SA(0, 1), cA + hstep, voffA);
        if (wr == 1) PG8_BAR;
        PG8_WAIT_V(2); PG8_BAR;
        PG8_STAGE(PG8_SB(1, 0), cB + kstep, voffB); PG8_STAGE(PG8_SA(1, 0), cA + kstep, voffA); PG8_STAGE(PG8_SB(1, 1), cB + hstep + kstep, voffB);
        PG8_WAIT_V(6); PG8_BAR;
    } else {
        PG8_STAGE(PG8_SB(0, 0), cB, voffB); PG8_STAGE(PG8_SA(0, 0), cA, voffA); PG8_STAGE(PG8_SB(0, 1), cB + hstep, voffB); PG8_STAGE(PG8_SA(0, 1), cA + hstep, voffA);
        if (wr == 1) PG8_BAR;
        PG8_WAIT_V(4); PG8_BAR;
        PG8_STAGE(PG8_SB(1, 0), cB + kstep, voffB); PG8_STAGE(PG8_SA(1, 0), cA + kstep, voffA); PG8_STAGE(PG8_SB(1, 1), cB + hstep + kstep, voffB);
        PG8_WAIT_V(6); PG8_BAR;
    }
    for (;;) {
        const bool has_next = S.next(ui + 1, nxt);
        const char* nA = has_next ? (const char*)g.A + (size_t)nxt.pm * tstep : cA; const char* nB = has_next ? (const char*)g.Bt + (size_t)nxt.pn * tstep : cB;
        for (int t = 0; t < nt; t += 2) {
            const bool last = (t == nt - 2);
            const char* a1 = cA + (size_t)(t + 1) * kstep;
            const char* a2 = last ? nA : cA + (size_t)(t + 2) * kstep; const char* b2 = last ? nB : cB + (size_t)(t + 2) * kstep;
            const char* a3 = a2 + kstep; const char* b3 = b2 + kstep;
            if (last && has_next) S.a_ready(nxt);
            if constexpr (SP2) {
            PG8_LDB(B0, 0, 0); PG8_LDB(B1, 0, 1); PG8_SCHED; PG8_LDA(At, 0, 0); PG8_STAGE(PG8_SA(1, 1), a1 + hstep, voffA);
            PG8_WAIT_V(8); PG8_WAIT_L(0); PG8_BAR; PG8_MMA(0, 0, At, B0); PG8_MMA(0, 1, At, B1); PG8_BAR; PG8_SCHED;
            PG8_LDA(At, 0, 1); PG8_STAGE(PG8_SB(0, 0), b2, voffB); PG8_STAGE(PG8_SB(0, 1), b2 + hstep, voffB); PG8_STAGE(PG8_SA(0, 0), a2, voffA);
            PG8_WAIT_V(8); PG8_WAIT_L(0); PG8_BAR; PG8_MMA(1, 0, At, B0); PG8_MMA(1, 1, At, B1); PG8_BAR; PG8_SCHED;
            PG8_LDB(B0, 1, 0); PG8_LDB(B1, 1, 1); PG8_SCHED; PG8_LDA(At, 1, 0); PG8_STAGE(PG8_SA(0, 1), a2 + hstep, voffA);
            PG8_WAIT_V(8); PG8_WAIT_L(0); PG8_BAR; PG8_MMA(0, 0, At, B0); PG8_MMA(0, 1, At, B1); PG8_BAR; PG8_SCHED;
            PG8_LDA(At, 1, 1); PG8_STAGE(PG8_SB(1, 0), b3, voffB); PG8_STAGE(PG8_SB(1, 1), b3 + hstep, voffB); PG8_STAGE(PG8_SA(1, 0), a3, voffA);
            PG8_WAIT_V(8); PG8_WAIT_L(0); PG8_BAR; PG8_MMA(1, 0, At, B0); PG8_MMA(1, 1, At, B1); PG8_BAR; PG8_SCHED;
            } else {
            PG8_LDB(B0, 0, 0); PG8_SCHED; PG8_LDA(At, 0, 0); PG8_STAGE(PG8_SA(1, 1), a1 + hstep, voffA);
            PG8_WAIT_L(8); PG8_BAR; PG8_WAIT_L(0); PG8_MMA(0, 0, At, B0); PG8_BAR; PG8_SCHED;
            PG8_LDB(B1, 0, 1); PG8_STAGE(PG8_SB(0, 0), b2, voffB);
            PG8_BAR; PG8_WAIT_L(0); PG8_MMA(0, 1, At, B1); PG8_BAR;
            PG8_LDA(At, 0, 1); PG8_STAGE(PG8_SA(0, 0), a2, voffA);
            PG8_BAR; PG8_WAIT_L(0); PG8_MMA(1, 0, At, B0); PG8_BAR; PG8_SCHED;
            PG8_STAGE(PG8_SB(0, 1), b2 + hstep, voffB);
            PG8_WAIT_V(6); PG8_BAR; PG8_MMA(1, 1, At, B1); PG8_BAR;
            PG8_LDB(B0, 1, 0); PG8_SCHED; PG8_LDA(At, 1, 0); PG8_STAGE(PG8_SA(0, 1), a2 + hstep, voffA);
            PG8_WAIT_L(8); PG8_BAR; PG8_WAIT_L(0); PG8_MMA(0, 0, At, B0); PG8_BAR; PG8_SCHED;
            PG8_LDB(B1, 1, 1); PG8_STAGE(PG8_SB(1, 0), b3, voffB);
            PG8_BAR; PG8_WAIT_L(0); PG8_MMA(0, 1, At, B1); PG8_BAR;
            PG8_LDA(At, 1, 1); PG8_STAGE(PG8_SA(1, 0), a3, voffA);
            PG8_BAR; PG8_WAIT_L(0); PG8_MMA(1, 0, At, B0); PG8_BAR; PG8_SCHED;
            PG8_STAGE(PG8_SB(1, 1), b3 + hstep, voffB);
            PG8_WAIT_V(6); PG8_BAR; PG8_MMA(1, 1, At, B1); PG8_BAR;
            }
            if constexpr (Epi::RESCALE) { if ((((t + 2) & 15) == 0) && (t + 2 < nt)) E.rescale(acc, cur, (t + 2) >> 4, wr, wc, fr, fq); }
        }
        if constexpr (ALIGN_EPI) { if (wr == 0) PG8_BAR; }
        if constexpr (!Epi::AFTER_DRAIN) { E(acc, cur, wr, wc, fr, fq); S.done(cur); }
        if (!has_next) break;
#pragma unroll
        for (int a = 0; a < 2; ++a)
#pragma unroll
            for (int b = 0; b < 2; ++b)
#pragma unroll
                for (int m = 0; m < 4; ++m)
#pragma unroll
                    for (int n = 0; n < 2; ++n) acc[a][b][m][n] = (f32x4){0.f, 0.f, 0.f, 0.f};
        cur = nxt; cA = nA; cB = nB; ++ui;
        if constexpr (ALIGN_EPI) { if (wr == 1) PG8_BAR; }
    }
    PG8_WAIT_V(0);
    if constexpr (!ALIGN_EPI) { if (wr == 0) PG8_BAR; }
    PG8_BAR;
    if constexpr (Epi::AFTER_DRAIN) { E.fused(acc, cur, wr, wc, fr, fq, lds, wid, lane); S.done(cur); }
#undef PG8_SA
#undef PG8_SB
#undef PG8_STAGE
#undef PG8_LDA
#undef PG8_LDB
#undef PG8_MMA
#undef PG8_WAIT_V
#undef PG8_WAIT_L
#undef PG8_BAR
#undef PG8_SCHED
}
}
#define XB_TMO      128
#define XB_XCNT(j)  (256  + 64 * (j))
#define XB_XSUB(j)  (1280 + 64 * (j))
#define XB_XGEN(j)  (2304 + 64 * (j))
#define XB_TOP      3328
#define XB_TOPGEN   3392
#define XCD_BAR_WORDS 3456
#define XB_SPIN_CAP (1u << 18)
#define LAS __attribute__((address_space(3)))

__device__ __forceinline__ unsigned xb_ld(unsigned* p)              { return __hip_atomic_load(p, __ATOMIC_RELAXED, __HIP_MEMORY_SCOPE_AGENT); }
__device__ __forceinline__ unsigned xb_add(unsigned* p, unsigned v) { return __hip_atomic_fetch_add(p, v, __ATOMIC_RELAXED, __HIP_MEMORY_SCOPE_AGENT); }
__device__ __forceinline__ unsigned xb_xcc_id() { return (unsigned)__builtin_amdgcn_s_getreg((3 << 11) | 20) & 0xFu; }
#define XB_SPIN(cond, bar) do { unsigned _sp = 0; while (cond) { __builtin_amdgcn_s_sleep(1); \
    if ((++_sp & 255u) == 0u) { if (xb_ld(&(bar)[XB_TMO])) break; if (_sp > XB_SPIN_CAP) { atomicAdd(&(bar)[XB_TMO], 1u); break; } } } } while (0)

struct XcdBarrier {
    unsigned* bar; unsigned x;
    volatile LAS unsigned* st;
};

__device__ __forceinline__ XcdBarrier xcd_barrier_post(unsigned* bar, volatile LAS unsigned* st) {
    XcdBarrier b; b.bar = bar; b.x = xb_xcc_id(); b.st = st;
    if (threadIdx.x == 0) (void)xb_add(&bar[XB_XCNT(b.x)], 1u);
    return b;
}
__device__ __forceinline__ void xcd_barrier_complete(unsigned* bar, unsigned x, unsigned& nloc, unsigned& nx) {
    const unsigned G = gridDim.x * gridDim.y * gridDim.z;
    unsigned sum, cnt, mine, sp = 0u;
    for (;;) {
        sum = 0u; cnt = 0u; mine = 0u;
#pragma unroll
        for (unsigned j = 0; j < 16; ++j) { const unsigned c = xb_ld(&bar[XB_XCNT(j)]); sum += c; cnt += (c > 0u) ? 1u : 0u; mine = (j == x) ? c : mine; }
        if (sum == G) break;
        __builtin_amdgcn_s_sleep(1);
        if ((++sp & 255u) == 0u) { if (xb_ld(&bar[XB_TMO])) break; if (sp > XB_SPIN_CAP) { atomicAdd(&bar[XB_TMO], 1u); break; } }
    }
    nloc = mine > 0u ? mine : 1u; nx = cnt > 0u ? cnt : 1u;
}

__device__ __forceinline__ void xcd_barrier(const XcdBarrier& b, const bool t0  ) {
    asm volatile("s_waitcnt vmcnt(0)" ::: "memory");
    __syncthreads();
    if (t0) {
        unsigned* bar = b.bar;
        __builtin_amdgcn_s_waitcnt(0);
        unsigned nloc = b.st[0], nx = b.st[1];
        if (nloc == 0u) { xcd_barrier_complete(bar, b.x, nloc, nx); b.st[0] = nloc; b.st[1] = nx; }
        const unsigned old = xb_add(&bar[XB_XSUB(b.x)], 1u);
        const unsigned gen = old / nloc;
        if (old + 1u == (gen + 1u) * nloc) {
            __builtin_amdgcn_fence(__ATOMIC_RELEASE, "agent");
            asm volatile("s_waitcnt vmcnt(0)" ::: "memory");
            const unsigned og = xb_add(&bar[XB_TOP], 1u);
            const unsigned tg = og / nx;
            if (og + 1u == (tg + 1u) * nx) xb_add(&bar[XB_TOPGEN], 1u);
            else XB_SPIN(xb_ld(&bar[XB_TOPGEN]) == tg, bar);
            __builtin_amdgcn_fence(__ATOMIC_ACQUIRE, "agent");
            xb_add(&bar[XB_XGEN(b.x)], 1u);
            asm volatile("s_waitcnt vmcnt(0)" ::: "memory");
        } else {
            XB_SPIN(xb_ld(&bar[XB_XGEN(b.x)]) == gen, bar);
            __builtin_amdgcn_fence(__ATOMIC_ACQUIRE, "agent");
            asm volatile("s_waitcnt vmcnt(0)" ::: "memory");
        }
    }
    __syncthreads();
}
constexpr int NWAVES = 8, NTHR = 512;
constexpr int LDS_CTL_OFF = 139264;
constexpr int LDS_BYTES = 147456;
#define MFMA16(a, b, c) __builtin_amdgcn_mfma_f32_16x16x32_bf16((a), (b), (c), 0, 0, 0)
#define MFMA32(a, b, c) __builtin_amdgcn_mfma_f32_32x32x16_bf16((a), (b), (c), 0, 0, 0)
__device__ __forceinline__ int crow(int reg, int h) { return (reg & 3) + 8 * (reg >> 2) + 4 * h; }

__device__ __forceinline__ void tr_tile(const float* W, int N, bf16* WT, int ldo, int koff, LAS float* scr  , int k0, int n0, int lane) {
#pragma unroll 8
    for (int kk = 0; kk < 64; ++kk) scr[kk * 65 + lane] = W[(size_t)(k0 + kk) * N + n0 + lane];
    asm volatile("s_waitcnt lgkmcnt(0)" ::: "memory");
    const int c = lane & 7;
#pragma unroll
    for (int j = 0; j < 8; ++j) {
        const int n = (lane >> 3) + 8 * j; const LAS float* s = scr + (8 * c) * 65 + n;
        u32x4 o; o.x = pk2(s[0], s[65]); o.y = pk2(s[2 * 65], s[3 * 65]); o.z = pk2(s[4 * 65], s[5 * 65]); o.w = pk2(s[6 * 65], s[7 * 65]);
        *(u32x4*)(WT + (size_t)(n0 + n) * ldo + koff + k0 + 8 * c) = o;
    }
    asm volatile("s_waitcnt lgkmcnt(0)" ::: "memory");
}
struct ConvSrc { const float *w_in, *w_glu, *w_branch, *w_out, *w_mi, *w_mo; };
__device__ __forceinline__ void phase_conv(const ConvSrc& S, unsigned char* ws, LAS unsigned char* lds, int gw, int ngw, int wave, int lane) {
    LAS float* scr = (LAS float*)(lds + wave * 16640);
    constexpr int T_IN = 32 * 192, T_GLU = 16 * 16, T_BR = 3 * 16 * 32, T_OUT = 32 * 32, T_MI = 32 * 128, T_MO = 128 * 32, TL = T_IN + T_GLU + T_BR + T_OUT + T_MI + T_MO;
    for (int it = gw; it < DEPTH * TL; it += ngw) {
        const int l = it / TL; int r = it % TL; unsigned char* wl = ws + WS_W + (size_t)l * WL_SIZE;
        if (r < T_IN) { tr_tile(S.w_in + (size_t)l * D * PC, PC, (bf16*)(wl + WL_IN), D, 0, scr, (r / 192) * 64, (r % 192) * 64, lane); continue; } r -= T_IN;
        if (r < T_GLU) { tr_tile(S.w_glu + (size_t)l * MW * MW, MW, (bf16*)(wl + WL_GLU), MW, 0, scr, (r / 16) * 64, (r % 16) * 64, lane); continue; } r -= T_GLU;
        if (r < T_BR) { const int n3 = r / 512, rr = r % 512; tr_tile(S.w_branch + ((size_t)l * 3 + n3) * MW * D, D, (bf16*)(wl + WL_BR), 3 * MW, n3 * MW, scr, (rr / 32) * 64, (rr % 32) * 64, lane); continue; } r -= T_BR;
        if (r < T_OUT) { tr_tile(S.w_out + (size_t)l * D * D, D, (bf16*)(wl + WL_OUT), D, 0, scr, (r / 32) * 64, (r % 32) * 64, lane); continue; } r -= T_OUT;
        if (r < T_MI) { tr_tile(S.w_mi + (size_t)l * D * DFF, DFF, (bf16*)(wl + WL_MI), D, 0, scr, (r / 128) * 64, (r % 128) * 64, lane); continue; } r -= T_MI;
        tr_tile(S.w_mo + (size_t)l * DFF * D, D, (bf16*)(wl + WL_MO), DFF, 0, scr, (r / 32) * 64, (r % 32) * 64, lane);
    }
}

struct S5Src { const float *lre, *lim, *ldt, *bre, *bim, *cre, *cim, *dd; };
__device__ __forceinline__ void phase_s5prep(const S5Src& S, unsigned char* ws, LAS unsigned char* lds, int tid) {
    LAS f32x2* pw = (LAS f32x2*)(lds);
    LAS f32x2* Bb = (LAS f32x2*)(lds + 8704);
    LAS f32x2* Cc = (LAS f32x2*)(lds + 16896);
    LAS float* Km = (LAS float*)(lds + 25088);
    for (int item = blockIdx.x; item < DEPTH * 64; item += gridDim.x) {
        const int l = item >> 6, g = item & 63; unsigned char* wl = ws + WS_W + (size_t)l * WL_SIZE;
        bf16* Wst = (bf16*)(wl + WL_WST) + (size_t)g * 128 * 256; bf16* W2 = (bf16*)(wl + WL_W2) + (size_t)g * 256 * 384; float2* A16 = (float2*)(wl + WL_A16) + g * 64;
        __syncthreads();
        if (tid < 64) {
            const int p = tid; const float dt = expf(S.ldt[l * 64 + g]); const float lr = S.lre[(l * 64 + g) * 64 + p], li = S.lim[(l * 64 + g) * 64 + p];
            const float mag = expf(lr * dt); float sn, cs; sincosf(li * dt, &sn, &cs);
            const float ar = mag * cs, ai = mag * sn; const float den = lr * lr + li * li; const float nr = ar - 1.f, ni = ai;
            const float kr = (nr * lr + ni * li) / den, ki = (ni * lr - nr * li) / den;
            float xr = 1.f, xi = 0.f; pw[p] = (f32x2){1.f, 0.f};
            for (int m = 1; m <= 16; ++m) { const float tr = xr * ar - xi * ai, ti = xr * ai + xi * ar; xr = tr; xi = ti; pw[m * 64 + p] = (f32x2){xr, xi}; }
            for (int h = 0; h < 16; ++h) { const float x = S.bre[((size_t)(l * 64 + g) * 64 + p) * 16 + h], y = S.bim[((size_t)(l * 64 + g) * 64 + p) * 16 + h]; Bb[p * 16 + h] = (f32x2){kr * x - ki * y, kr * y + ki * x}; }
        } else {
            for (int e = tid - 64; e < 1024; e += NTHR - 64) Cc[e] = (f32x2){S.cre[(size_t)(l * 64 + g) * 1024 + e], S.cim[(size_t)(l * 64 + g) * 1024 + e]};
        }
        __syncthreads();
        for (int e = tid; e < 4096; e += NTHR) {
            const int m = e >> 8, hp = (e >> 4) & 15, h = e & 15; float s = 0.f;
            for (int p = 0; p < 64; ++p) { const f32x2 c = Cc[hp * 64 + p], a = pw[m * 64 + p], b = Bb[p * 16 + h]; const float cr = c.x * a.x - c.y * a.y, ci = c.x * a.y + c.y * a.x; s += cr * b.x - ci * b.y; }
            Km[e] = s + ((m == 0 && hp == h) ? S.dd[l * MW + g * 16 + h] : 0.f);
        }
        __syncthreads();
        for (int e = tid; e < 128 * 256; e += NTHR) {
            const int o = e >> 8, k = e & 255, i = k >> 4, h = k & 15, p = o & 63; const f32x2 a = pw[(15 - i) * 64 + p], b = Bb[p * 16 + h];
            Wst[e] = f2bf(o < 64 ? a.x * b.x - a.y * b.y : a.x * b.y + a.y * b.x);
        }
        for (int e = tid; e < 256 * 384; e += NTHR) {
            const int o = e / 384, k = e % 384, j = o >> 4, hp = o & 15; float v;
            if (k < 256) { const int i = k >> 4, h = k & 15; v = (j >= i) ? Km[((j - i) * 16 + hp) * 16 + h] : 0.f; }
            else { const int p = (k - 256) & 63; const f32x2 c = Cc[hp * 64 + p], a = pw[(j + 1) * 64 + p]; v = (k < 320) ? (c.x * a.x - c.y * a.y) : -(c.x * a.y + c.y * a.x); }
            W2[e] = f2bf(v);
        }
        if (tid < 64) { const f32x2 q = pw[16 * 64 + tid]; A16[tid] = make_float2(q.x, q.y); }
    }
}

__device__ __forceinline__ void phase_rmsnorm_bf16(const float* x, const float* g, bf16* out, int gw, int ngw, int lane) {
    for (int row = gw; row < M; row += ngw) {
        const f32x4* xr = (const f32x4*)(x + (size_t)row * D) + lane; f32x4 v[8]; float s = 0.f;
#pragma unroll
        for (int j = 0; j < 8; ++j) { v[j] = xr[64 * j]; s += (v[j].x * v[j].x + v[j].y * v[j].y) + (v[j].z * v[j].z + v[j].w * v[j].w); }
        const float rstd = rsqrtf(wave_sum(s) * (1.f / D) + EPS);
        const f32x4* gr = (const f32x4*)g + lane; u32x2* o = (u32x2*)(out + (size_t)row * D) + lane;
#pragma unroll
        for (int j = 0; j < 8; ++j) { const f32x4 gg = gr[64 * j]; u32x2 w; w.x = pk2(v[j].x * rstd * gg.x, v[j].y * rstd * gg.y); w.y = pk2(v[j].z * rstd * gg.z, v[j].w * rstd * gg.w); o[64 * j] = w; }
    }
}
__device__ __forceinline__ void phase_rmsnorm_f32(const float* x, const float* g, float* out, int gw, int ngw, int lane) {
    for (int row = gw; row < M; row += ngw) {
        const f32x4* xr = (const f32x4*)(x + (size_t)row * D) + lane; f32x4 v[8]; float s = 0.f;
#pragma unroll
        for (int j = 0; j < 8; ++j) { v[j] = xr[64 * j]; s += (v[j].x * v[j].x + v[j].y * v[j].y) + (v[j].z * v[j].z + v[j].w * v[j].w); }
        const float rstd = rsqrtf(wave_sum(s) * (1.f / D) + EPS);
        const f32x4* gr = (const f32x4*)g + lane; f32x4* o = (f32x4*)(out + (size_t)row * D) + lane;
#pragma unroll
        for (int j = 0; j < 8; ++j) { const f32x4 gg = gr[64 * j]; o[64 * j] = (f32x4){v[j].x * rstd * gg.x, v[j].y * rstd * gg.y, v[j].z * rstd * gg.z, v[j].w * rstd * gg.w}; }
    }
}

__device__ __forceinline__ void stage_gmlp(const bf16* P, const float* vsq, const float* gng, const float* wsl, const float* bsl, bf16* YS, LAS unsigned char* lds, int unit, int tid, int wave, int lane) {
    const int c = unit >> 3, g = unit & 7, row0 = c * 128;
    LAS float* rs = (LAS float*)lds;
    LAS bf16* Vt = (LAS bf16*)(lds + 512);
    __syncthreads();
    if (tid < 128) { const f32x4* q = (const f32x4*)(vsq + (size_t)(row0 + tid) * 16); const f32x4 a = q[0], b = q[1], cc = q[2], d = q[3];
        const float s = ((a.x + a.y) + (a.z + a.w)) + ((b.x + b.y) + (b.z + b.w)) + ((cc.x + cc.y) + (cc.z + cc.w)) + ((d.x + d.y) + (d.z + d.w)); rs[tid] = rsqrtf(s * (1.f / MW) + EPS); }
#pragma unroll
    for (int i = 0; i < 4; ++i) { const int idx = tid + NTHR * i, s = idx >> 4, cc = idx & 15; const u32x4 v = *(const u32x4*)(P + (size_t)(row0 + s) * PC + OFF_V + g * 128 + 8 * cc); *(LAS u32x4*)(Vt + s * 136 + 8 * cc) = v; }
    __syncthreads();
    const int tq = wave >> 1, chh = wave & 1, r = lane & 31, hh = lane >> 5, t0 = 32 * tq, t = t0 + r;
    f32x16 acc[2];
#pragma unroll
    for (int i = 0; i < 16; ++i) { acc[0][i] = 0.f; acc[1][i] = 0.f; }
    for (int ks = 0; ks <= 2 * tq + 1; ++ks) {
        const int sb = 16 * ks + 8 * hh;
        const float* wp = wsl + (size_t)(g * 128 + t) * 128 + sb; const f32x4 w0 = *(const f32x4*)wp, w1 = *(const f32x4*)(wp + 4);
        const f32x4 r0 = *(const LAS f32x4*)(rs + sb), r1 = *(const LAS f32x4*)(rs + sb + 4);
        float av[8] = {w0.x * r0.x, w0.y * r0.y, w0.z * r0.z, w0.w * r0.w, w1.x * r1.x, w1.y * r1.y, w1.z * r1.z, w1.w * r1.w};
        u32x4 ap;
#pragma unroll
        for (int j = 0; j < 4; ++j) { const float lo = (sb + 2 * j <= t) ? av[2 * j] : 0.f, hi = (sb + 2 * j + 1 <= t) ? av[2 * j + 1] : 0.f; ap[j] = pk2(lo, hi); }
        const bf16x8 a = __builtin_bit_cast(bf16x8, ap);
#pragma unroll
        for (int ct = 0; ct < 2; ++ct) {
            const int h = 64 * chh + 32 * ct + r; u32x4 bp;
#pragma unroll
            for (int j = 0; j < 4; ++j) bp[j] = (unsigned)Vt[(sb + 2 * j) * 136 + h] | ((unsigned)Vt[(sb + 2 * j + 1) * 136 + h] << 16);
            acc[ct] = MFMA32(a, __builtin_bit_cast(bf16x8, bp), acc[ct]);
        }
    }
#pragma unroll
    for (int ct = 0; ct < 2; ++ct) {
        const int h = 64 * chh + 32 * ct + r, ch = g * 128 + h; const float gn = gng[ch];
#pragma unroll
        for (int i = 0; i < 16; ++i) { const int tt = t0 + crow(i, hh); const float mixed = gn * acc[ct][i] + bsl[g * 128 + tt];
            const float u = bf2f(P[(size_t)(row0 + tt) * PC + OFF_U + ch]); YS[(size_t)(row0 + tt) * YSW + ch] = f2bf(u * mixed); }
    }
}

__device__ __forceinline__ void stage_s5a(const bf16* P, const bf16* Wst_l, const float2* A16_l, bf16* Sst, LAS unsigned char* lds, int unit, int wave, int lane) {
    const int b = unit >> 6, g = unit & 63, fr = lane & 15, fq = lane >> 4;
    LAS float* Sl = (LAS float*)lds;
    const bf16* wst = Wst_l + (size_t)g * 128 * 256;
    __syncthreads();
#pragma unroll 1
    for (int rti = 0; rti < 2; ++rti) {
        const int rt = 2 * wave + rti; bf16x8 af[8];
#pragma unroll
        for (int ks = 0; ks < 8; ++ks) af[ks] = *(const bf16x8*)(P + (size_t)(b * SEQ + 16 * (16 * rt + fr) + 2 * ks + (fq >> 1)) * PC + OFF_S5 + g * 16 + 8 * (fq & 1));
#pragma unroll 2
        for (int ct = 0; ct < 8; ++ct) {
            f32x4 acc = {0.f, 0.f, 0.f, 0.f};
#pragma unroll
            for (int ks = 0; ks < 8; ++ks) acc = MFMA16(af[ks], *(const bf16x8*)(wst + (size_t)(16 * ct + fr) * 256 + 32 * ks + 8 * fq), acc);
#pragma unroll
            for (int jj = 0; jj < 4; ++jj) Sl[(16 * rt + 4 * fq + jj) * 128 + 16 * ct + fr] = acc[jj];
        }
    }
    __syncthreads();
    if (wave == 0) {
        const float2 a = A16_l[g * 64 + lane]; float sr = 0.f, si = 0.f; bf16* dst = Sst + (size_t)(b * 64 + g) * 256 * 128;
        for (int c = 0; c < 256; ++c) {
            dst[c * 128 + lane] = f2bf(sr); dst[c * 128 + 64 + lane] = f2bf(si);
            const float x = Sl[c * 128 + lane], y = Sl[c * 128 + 64 + lane];
            const float nr = a.x * sr - a.y * si + x, ni = a.x * si + a.y * sr + y; sr = nr; si = ni;
        }
    }
}

__device__ __forceinline__ void stage_s5b(const bf16* P, const bf16* Sst, const bf16* W2_l, bf16* G, int unit, int wave, int lane) {
    const int b = unit >> 7, g = (unit >> 1) & 63, half = unit & 1, rt = 8 * half + wave, fr = lane & 15, fq = lane >> 4;
    bf16x8 af[12];
#pragma unroll
    for (int ks = 0; ks < 8; ++ks) af[ks] = *(const bf16x8*)(P + (size_t)(b * SEQ + 16 * (16 * rt + fr) + 2 * ks + (fq >> 1)) * PC + OFF_S5 + g * 16 + 8 * (fq & 1));
#pragma unroll
    for (int ks = 8; ks < 12; ++ks) af[ks] = *(const bf16x8*)(Sst + ((size_t)(b * 64 + g) * 256 + 16 * rt + fr) * 128 + 32 * (ks - 8) + 8 * fq);
    const bf16* w2 = W2_l + (size_t)g * 256 * 384;
#pragma unroll 2
    for (int ct = 0; ct < 16; ++ct) {
        f32x4 acc = {0.f, 0.f, 0.f, 0.f};
#pragma unroll
        for (int ks = 0; ks < 12; ++ks) acc = MFMA16(af[ks], *(const bf16x8*)(w2 + (size_t)(16 * ct + fr) * 384 + 32 * ks + 8 * fq), acc);
#pragma unroll
        for (int jj = 0; jj < 4; ++jj) { const int cc = 16 * rt + 4 * fq + jj; G[(size_t)(b * SEQ + 16 * cc + ct) * MW + g * 16 + fr] = f2bf(gelu_t(acc[jj])); }
    }
}

__device__ __forceinline__ void stage_attn(const bf16* P, bf16* YS, LAS unsigned char* lds, int unit, int wave, int lane) {
    const int b = unit >> 7, hd = (unit >> 4) & 7, qb = unit & 15, t0 = 256 * qb + 32 * wave, r = lane & 31, hh = lane >> 5;
    const bf16* base = P + (size_t)b * SEQ * PC;
    LAS bf16* Vs = (LAS bf16*)(lds + wave * 8192);
    bf16x8 qf[8];
#pragma unroll
    for (int ks = 0; ks < 8; ++ks) qf[ks] = *(const bf16x8*)(base + (size_t)(t0 + r) * PC + OFF_Q + hd * 128 + 16 * ks + 8 * hh);
    f32x16 o[4];
#pragma unroll
    for (int dt = 0; dt < 4; ++dt)
#pragma unroll
        for (int i = 0; i < 16; ++i) o[dt][i] = 0.f;
    float R = 0.f; const float scale = 0.08838834764831845f;
    for (int s0 = t0; s0 >= 0; s0 -= 32) {
#pragma unroll
        for (int i = 0; i < 8; ++i) { const int row = (lane >> 4) + 4 * i; const u32x4 v = *(const u32x4*)(base + (size_t)(s0 + row) * PC + OFF_VV + hd * 128 + 8 * (lane & 15)); *(LAS u32x4*)(Vs + row * 128 + 8 * (lane & 15)) = v; }
        f32x16 z;
#pragma unroll
        for (int i = 0; i < 16; ++i) z[i] = 0.f;
#pragma unroll
        for (int ks = 0; ks < 8; ++ks) z = MFMA32(*(const bf16x8*)(base + (size_t)(s0 + r) * PC + OFF_K + hd * 128 + 16 * ks + 8 * hh), qf[ks], z);
        float L[16], zz[16], w[16];
#pragma unroll
        for (int i = 0; i < 16; ++i) { const bool valid = (s0 + crow(i, hh)) < (t0 + r); zz[i] = z[i] * scale; L[i] = valid ? -softplus_f(zz[i]) : 0.f; }
        float gs[4], pg[4], aft[4];
#pragma unroll
        for (int gi = 0; gi < 4; ++gi) { gs[gi] = (L[4 * gi] + L[4 * gi + 1]) + (L[4 * gi + 2] + L[4 * gi + 3]); pg[gi] = __shfl_xor(gs[gi], 32); }
        float run = 0.f;
#pragma unroll
        for (int gi = 3; gi >= 0; --gi) { aft[gi] = hh ? run : run + pg[gi]; run += gs[gi] + pg[gi]; }
#pragma unroll
        for (int gi = 0; gi < 4; ++gi) {
            float inc = aft[gi] + R;
#pragma unroll
            for (int j = 3; j >= 0; --j) { const int i = 4 * gi + j; inc += L[i]; const bool valid = (s0 + crow(i, hh)) < (t0 + r); w[i] = valid ? __expf(zz[i] + inc) : 0.f; }
        }
        R += run;
#pragma unroll
        for (int s = 0; s < 2; ++s) {
            u32x4 wp;
#pragma unroll
            for (int j = 0; j < 4; ++j) wp[j] = pk2(w[8 * s + 2 * j], w[8 * s + 2 * j + 1]);
            const bf16x8 wf = __builtin_bit_cast(bf16x8, wp);
#pragma unroll
            for (int dt = 0; dt < 4; ++dt) {
                u32x4 vp;
#pragma unroll
                for (int j = 0; j < 4; ++j) { const int k0 = 16 * s + 8 * ((2 * j) >> 2) + 4 * hh + ((2 * j) & 3); vp[j] = (unsigned)Vs[k0 * 128 + 32 * dt + r] | ((unsigned)Vs[(k0 + 1) * 128 + 32 * dt + r] << 16); }
                o[dt] = MFMA32(__builtin_bit_cast(bf16x8, vp), wf, o[dt]);
            }
        }
        if (__all(R < -104.f)) break;
    }
    bf16* orow = YS + (size_t)(b * SEQ + t0 + r) * YSW + 2 * MW + hd * 128;
#pragma unroll
    for (int dt = 0; dt < 4; ++dt)
#pragma unroll
        for (int gi = 0; gi < 4; ++gi) { u32x2 v; v.x = pk2(o[dt][4 * gi], o[dt][4 * gi + 1]); v.y = pk2(o[dt][4 * gi + 2], o[dt][4 * gi + 3]); *(u32x2*)(orow + 32 * dt + 8 * gi + 4 * hh) = v; }
}
#ifndef MK_SUB
#define MK_SUB 7
#endif
#ifndef MK_ONLY_PRO
#define MK_ONLY_PRO 1
#endif
#ifndef MK_ONLY_FIN
#define MK_ONLY_FIN 1
#endif
struct Args { const float* in[23]; float* out; unsigned char* ws; int l_lo, l_hi, ph_lo, ph_hi, pro, fin; };
constexpr int NPH = 10;
__global__ void __launch_bounds__(NTHR, 2) mk_fwd(Args a) {
    extern __shared__ __attribute__((aligned(16))) unsigned char lds_raw[];
    LAS unsigned char* lds = (LAS unsigned char*)lds_raw;
    const int wave_s = __builtin_amdgcn_readfirstlane(threadIdx.x >> 6);
    const int G = gridDim.x, ngw = G * NWAVES;
    unsigned char* ws = a.ws;
    for (int u = threadIdx.x; u < (LDS_BYTES - LDS_CTL_OFF) / 4; u += NTHR) ((LAS unsigned*)(lds + LDS_CTL_OFF))[u] = 0u;
    __syncthreads();
    XcdBarrier bar = xcd_barrier_post((unsigned*)(ws + WS_CTL), (volatile LAS unsigned*)(lds + LDS_CTL_OFF));
    float* X = (float*)(ws + WS_X); bf16* H = (bf16*)(ws + WS_H); bf16* P = (bf16*)(ws + WS_PROJ); bf16* Gb = (bf16*)(ws + WS_G); bf16* YS = (bf16*)(ws + WS_YS);
    bf16* MG = (bf16*)(ws + WS_MERGED); bf16* HID = (bf16*)(ws + WS_HID); float* VSQ = (float*)(ws + WS_VSQ); bf16* SST = (bf16*)(ws + WS_SST);

#define LAUNDER() int lane_l, wave_l = wave_s, bid_l = blockIdx.x; asm volatile("v_mbcnt_lo_u32_b32 %0, -1, 0\n\tv_mbcnt_hi_u32_b32 %0, -1, %0" : "=v"(lane_l)); asm volatile("" : "+s"(wave_l), "+s"(bid_l)); const int lane = lane_l, wave = wave_l, bid = bid_l, tid = wave_l * 64 + lane_l, gw = bid_l * NWAVES + wave_l; (void)tid; (void)lane; (void)wave; (void)gw; (void)bid
    if ((MK_ONLY_PRO) && a.pro) {
        LAUNDER();
        const ConvSrc cs{a.in[2], a.in[15], a.in[17], a.in[18], a.in[20], a.in[21]};
        phase_conv(cs, ws, lds, gw, ngw, wave, lane);
        const S5Src ss{a.in[7], a.in[8], a.in[9], a.in[10], a.in[11], a.in[12], a.in[13], a.in[14]};
        phase_s5prep(ss, ws, lds, tid);
        xcd_barrier(bar, tid == 0);
    }
    for (int l = a.l_lo; l < a.l_hi; ++l) {
        unsigned char* wl = ws + WS_W + (size_t)l * WL_SIZE;
        const float* xsrc = (l == 0) ? a.in[0] : X;
#ifndef MK_ONLY
#define MK_ONLY -1
#endif
#ifndef MK_MASK
#define MK_MASK 0x3ff
#endif
#define IN(k) ((MK_ONLY < 0 || MK_ONLY == (k)) && ((MK_MASK >> (k)) & 1) && a.ph_lo <= (k) && (k) < a.ph_hi)
        if (IN(0)) { LAUNDER(); phase_rmsnorm_bf16(xsrc, a.in[1] + (size_t)l * D, H, gw, ngw, lane); xcd_barrier(bar, tid == 0); }
        if (IN(1)) {
            LAUNDER();
            pg8::Gemm g{H, (const bf16*)(wl + WL_IN), M, PC, D}; pg8::StaticOrder S; S.init(M, PC, G, bid);
            pg8::EpiProj E{P, a.in[3] + (size_t)l * 3 * D, VSQ};
            pg8::gemm_phase<pg8::EpiProj, pg8::StaticOrder, true, true>(lds, g, S, E, tid);
            xcd_barrier(bar, tid == 0);
        }
        if (IN(2)) {
            LAUNDER();
            if (MK_SUB & 1) for (int u = bid; u < 128; u += G) stage_s5a(P, (const bf16*)(wl + WL_WST), (const float2*)(wl + WL_A16), SST, lds, u, wave, lane);
            if (MK_SUB & 2) for (int u = bid; u < 512; u += G) stage_gmlp(P, VSQ, a.in[4] + (size_t)l * MW, a.in[5] + (size_t)l * 8 * 128 * 128, a.in[6] + (size_t)l * 8 * 128, YS, lds, u, tid, wave, lane);
            __syncthreads();
            if (MK_SUB & 4) for (int u = bid; u < 256; u += G) stage_attn(P, YS, lds, u, wave, lane);
            xcd_barrier(bar, tid == 0);
        }
        if (IN(3) && (MK_SUB & 1)) {
            LAUNDER();
            for (int u = bid; u < 256; u += G) stage_s5b(P, SST, (const bf16*)(wl + WL_W2), Gb, u, wave, lane);
            xcd_barrier(bar, tid == 0);
        }
        if (IN(4)) {
            LAUNDER();
            pg8::Gemm g{Gb, (const bf16*)(wl + WL_GLU), M, MW, MW}; pg8::StaticOrder S; S.init(M, MW, G, bid);
            pg8::EpiGlu E{Gb, a.in[16] + (size_t)l * MW, YS};
            pg8::gemm_phase<pg8::EpiGlu, pg8::StaticOrder, true, true>(lds, g, S, E, tid);
            xcd_barrier(bar, tid == 0);
        }
        if (IN(5)) {
            LAUNDER();
            pg8::Gemm g{YS, (const bf16*)(wl + WL_BR), M, D, 3 * MW}; pg8::StaticOrder S; S.init(M, D, G, bid);
            pg8::EpiBranch E{P, MG};
            pg8::gemm_phase<pg8::EpiBranch, pg8::StaticOrder, true, true>(lds, g, S, E, tid);
            xcd_barrier(bar, tid == 0);
        }
        if (IN(6)) {
            LAUNDER();
            pg8::Gemm g{MG, (const bf16*)(wl + WL_OUT), M, D, D}; pg8::StaticOrder S; S.init(M, D, G, bid);
            pg8::EpiRes E{xsrc, X};
            pg8::gemm_phase<pg8::EpiRes, pg8::StaticOrder, true, true>(lds, g, S, E, tid);
            xcd_barrier(bar, tid == 0);
        }
        if (IN(7)) { LAUNDER(); phase_rmsnorm_bf16(X, a.in[19] + (size_t)l * D, H, gw, ngw, lane); xcd_barrier(bar, tid == 0); }
        if (IN(8)) {
            LAUNDER();
            pg8::Gemm g{H, (const bf16*)(wl + WL_MI), M, DFF, D}; pg8::StaticOrder S; S.init(M, DFF, G, bid);
            pg8::EpiRelu2 E{HID};
            pg8::gemm_phase<pg8::EpiRelu2, pg8::StaticOrder, true, true>(lds, g, S, E, tid);
            xcd_barrier(bar, tid == 0);
        }
        if (IN(9)) {
            LAUNDER();
            pg8::Gemm g{HID, (const bf16*)(wl + WL_MO), M, D, DFF}; pg8::StaticOrder S; S.init(M, D, G, bid);
            pg8::EpiRes E{X, X};
            pg8::gemm_phase<pg8::EpiRes, pg8::StaticOrder, true, true>(lds, g, S, E, tid);
            xcd_barrier(bar, tid == 0);
        }
#undef IN
    }
    if ((MK_ONLY_FIN) && a.fin) { LAUNDER(); phase_rmsnorm_f32(X, a.in[22], a.out, gw, ngw, lane); }
}
#ifndef MK_MODE
#define MK_MODE 0
#endif
static void mk_launch(const Args& a0, int grid, hipStream_t stream, int pro, int fin, int l_lo, int l_hi, int ph_lo, int ph_hi) {
    Args a = a0; a.pro = pro; a.fin = fin; a.l_lo = l_lo; a.l_hi = l_hi; a.ph_lo = ph_lo; a.ph_hi = ph_hi;
    hipMemsetAsync(a.ws + WS_CTL, 0, 16384, stream);
    hipLaunchKernelGGL(mk_fwd, dim3(grid), dim3(NTHR), LDS_BYTES, stream, a);
}
extern "C" void kernel_launch(void* const* d_in, const int* in_sizes, int n_in, void* d_out, int out_size, void* d_ws, size_t ws_size, hipStream_t stream) {
    static int grid = 0;
    if (grid == 0) {
        if (n_in != 23 || out_size != M * D || ws_size < WS_END) { fprintf(stderr, "kernel_launch: unexpected shapes (n_in %d out %d ws %zu need %zu)\n", n_in, out_size, ws_size, (size_t)WS_END); grid = -1; return; }
        int dev = 0, cus = 0, per_cu = 0;
        if (hipGetDevice(&dev) != hipSuccess || hipDeviceGetAttribute(&cus, hipDeviceAttributeMultiprocessorCount, dev) != hipSuccess) { grid = -1; return; }
        if (hipFuncSetAttribute((const void*)mk_fwd, hipFuncAttributeMaxDynamicSharedMemorySize, LDS_BYTES) != hipSuccess) { fprintf(stderr, "kernel_launch: hipFuncSetAttribute failed\n"); grid = -1; return; }
        if (hipOccupancyMaxActiveBlocksPerMultiprocessor(&per_cu, (const void*)mk_fwd, NTHR, LDS_BYTES) != hipSuccess || per_cu < 1) { fprintf(stderr, "kernel_launch: occupancy query says %d\n", per_cu); }
        (void)hipGetLastError();
        grid = cus;
    }
    if (grid < 0) return;
    Args a{};
    for (int i = 0; i < 23; ++i) a.in[i] = (const float*)d_in[i];
    a.out = (float*)d_out; a.ws = (unsigned char*)d_ws;
#if MK_MODE == 0
    mk_launch(a, grid, stream, 1, 1, 0, DEPTH, 0, NPH);
#else
    unsigned char* ws = (unsigned char*)d_ws;
    bf16* P = (bf16*)(ws + WS_PROJ); bf16* G = (bf16*)(ws + WS_G); bf16* YS = (bf16*)(ws + WS_YS); float* VRS = (float*)(ws + WS_VRS); float2* SALL = (float2*)(ws + WS_SALL);
    const float* gm_norm_g = a.in[4]; const float* gm_w_s = a.in[5]; const float* gm_b_s = a.in[6];
    const float* lre = a.in[7]; const float* lim = a.in[8]; const float* ldt = a.in[9]; const float* bre = a.in[10]; const float* bim = a.in[11]; const float* cre = a.in[12]; const float* cim = a.in[13]; const float* s5d = a.in[14];
    mk_launch(a, grid, stream, 1, 0, 0, 0, 0, 0);
    for (int l = 0; l < DEPTH; ++l) {
        mk_launch(a, grid, stream, 0, 0, l, l + 1, 0, 2);
        if (MK_SUB) mk_launch(a, grid, stream, 0, 0, l, l + 1, 2, 4);
        if (!(MK_SUB & 2)) {
            hipLaunchKernelGGL(k_vrstd, dim3(2048), dim3(256), 0, stream, (const bf16*)P, VRS);
            hipLaunchKernelGGL(k_ogmlp, dim3(64 * 8), dim3(256), 0, stream, (const bf16*)P, (const float*)VRS, gm_norm_g + (size_t)l * MW, gm_w_s + (size_t)l * 8 * 128 * 128, gm_b_s + (size_t)l * 8 * 128, YS);
        }
        if (!(MK_SUB & 1)) {
            hipLaunchKernelGGL(k_os5_scan, dim3(BATCH * 64), dim3(64), 0, stream, (const bf16*)P, lre + (size_t)l * 4096, lim + (size_t)l * 4096, ldt + (size_t)l * 64, bre + (size_t)l * 65536, bim + (size_t)l * 65536, SALL);
            hipLaunchKernelGGL(k_os5_out, dim3(M * MW / 256), dim3(256), 0, stream, (const bf16*)P, (const float2*)SALL, cre + (size_t)l * 65536, cim + (size_t)l * 65536, s5d + (size_t)l * MW, G);
        }
        if (!(MK_SUB & 4)) hipLaunchKernelGGL(k_oattn, dim3(BATCH * 8 * SEQ), dim3(64), 0, stream, (const bf16*)P, YS);
        mk_launch(a, grid, stream, 0, 0, l, l + 1, 4, NPH);
    }
    mk_launch(a, grid, stream, 0, 1, 0, 0, 0, 0);
#endif
}
```

```cpp
#include <hip/hip_runtime.h>
#include <stdint.h>
#include <stdio.h>

typedef unsigned short bf16;
typedef short bf16x8 __attribute__((ext_vector_type(8)));
typedef float f32x4 __attribute__((ext_vector_type(4)));
typedef float f32x16 __attribute__((ext_vector_type(16)));
typedef unsigned u32x4 __attribute__((ext_vector_type(4)));
typedef unsigned u32x2 __attribute__((ext_vector_type(2)));
typedef float f32x2 __attribute__((ext_vector_type(2)));

constexpr int D = 2048, BATCH = 2, SEQ = 4096, DEPTH = 4, M = BATCH * SEQ;
constexpr int MW = 1024, PC = 12288, DFF = 8192;
constexpr int OFF_U = 0, OFF_V = 1024, OFF_S5 = 2048, OFF_Q = 3072, OFF_K = 4096, OFF_VV = 5120, OFF_G = 6144;
constexpr int YSW = 3072;
constexpr float EPS = 1e-6f;

constexpr size_t MiB = 1u << 20;
constexpr size_t WS_CTL = 0;
constexpr size_t WL_IN = 0, WL_GLU = 48 * MiB, WL_BR = 50 * MiB, WL_OUT = 62 * MiB, WL_MI = 70 * MiB, WL_MO = 102 * MiB;
constexpr size_t WL_WST = 134 * MiB;
constexpr size_t WL_W2 = 138 * MiB;
constexpr size_t WL_A16 = 150 * MiB;
constexpr size_t WL_SIZE = 151 * MiB;
constexpr size_t WS_W = 1 * MiB;
constexpr size_t WS_X = WS_W + DEPTH * WL_SIZE;
constexpr size_t WS_H = WS_X + 64 * MiB;
constexpr size_t WS_PROJ = WS_H + 32 * MiB;
constexpr size_t PJ_U = 0, PJ_VG = 16 * MiB;
constexpr size_t PJ_SIN = 32 * MiB;
constexpr size_t PJ_Q = 48 * MiB, PJ_K = 64 * MiB, PJ_V = 80 * MiB;
constexpr size_t PJ_GT = 96 * MiB;
constexpr size_t WS_G = WS_PROJ + 192 * MiB;
constexpr size_t WS_YS = WS_G + 16 * MiB;
constexpr size_t WS_MERGED = WS_YS + 48 * MiB;
constexpr size_t WS_HID = WS_MERGED + 32 * MiB;
constexpr size_t WS_VSQ = WS_HID + 128 * MiB;
constexpr size_t WS_SST = WS_VSQ + 1 * MiB;
constexpr size_t WS_RSQ = WS_SST + 8 * MiB;
constexpr size_t WS_VRS = WS_RSQ + 2 * MiB;
constexpr size_t WS_SALL = WS_VRS + 1 * MiB;
constexpr size_t WS_END = WS_SALL + 256 * MiB;

__device__ __forceinline__ float bf2f(bf16 v) { return __uint_as_float(((unsigned)v) << 16); }
typedef __bf16 bf16x2_t __attribute__((ext_vector_type(2)));
__device__ __forceinline__ unsigned pk2(float lo, float hi) { const f32x2 v = {lo, hi}; return __builtin_bit_cast(unsigned, __builtin_convertvector(v, bf16x2_t)); }
__device__ __forceinline__ bf16 f2bf(float f) { return (bf16)(pk2(f, 0.f) & 0xffffu); }
__device__ __forceinline__ float gelu_t(float x) { const float u = 0.7978845608028654f * (x + 0.044715f * x * x * x); return x * __builtin_amdgcn_rcpf(1.f + __expf(-2.f * u)); }
__device__ __forceinline__ float sigmoid_f(float x) { return __builtin_amdgcn_rcpf(1.f + __expf(-x)); }
__device__ __forceinline__ float softplus_f(float z) { return fmaxf(z, 0.f) + __logf(1.f + __expf(-fabsf(z))); }
__device__ __forceinline__ float wave_sum(float v) {
#pragma unroll
    for (int o = 1; o < 64; o <<= 1) v += __shfl_xor(v, o);
    return v;
}
__device__ __forceinline__ float bflo(unsigned w) { return __uint_as_float(w << 16); }
__device__ __forceinline__ float bfhi(unsigned w) { return __uint_as_float(w & 0xffff0000u); }
#define MK_MODE 0
#define MK_SUB 7
#define MK_DUP -1
#define STAG_NG 1
#define STAG_US 0
namespace pg8 {
#define PG8_LAS __attribute__((address_space(3)))
typedef unsigned short bf16_t;
typedef short bf16x8 __attribute__((ext_vector_type(8)));
typedef float f32x4 __attribute__((ext_vector_type(4)));
typedef unsigned u32x4 __attribute__((ext_vector_type(4)));
constexpr int BM = 256, BK = 64, HALF = 128, HTB = HALF * BK * 2  , STAGE_BYTES = 8 * HTB, NXCD = 8, WGM = 8;

__host__ __device__ __forceinline__ int lds_byte(int r, int c) { const int st = (r >> 4) * 2 + (c >> 5), rr = r & 15, cc = c & 31, ob = rr * 64 + cc * 2; return st * 1024 + (ob ^ (((ob >> 9) & 1) << 5)); }
__host__ __device__ __forceinline__ void stage_rc(int b, int& R, int& C) { const int st = b / 1024, sb = b % 1024, swz = sb ^ (((sb >> 9) & 1) << 5); R = (st >> 1) * 16 + swz / 64; C = (st & 1) * 32 + (swz % 64) / 2; }
__host__ __device__ __forceinline__ int perm32(int rho) { const int n = rho >> 4, i = rho & 15; return 8 * (i >> 2) + 4 * n + (i & 3); }

struct Unit { int pm, pn; };
struct Gemm { const bf16_t* A; const bf16_t* Bt; int M, N, K; };

struct StaticOrder {
    int nM, nN, nwg, G, c;
    __host__ __device__ void init(int M, int N, int G_, int c_) { nM = M / BM; nN = N / BM; nwg = nM * nN; G = G_; c = c_; }
    __host__ __device__ bool next(int i, Unit& u) const {
        const long L = (long)i * G + c; if (L >= nwg) return false;
        int wgid = (int)L; { const int q = nwg / NXCD, r = nwg % NXCD, xcd = wgid % NXCD, off = wgid / NXCD; wgid = (xcd < r ? xcd * (q + 1) : r * (q + 1) + (xcd - r) * q) + off; }
        const int nig = WGM * nN, gid = wgid / nig, fm = gid * WGM, gsz = (nM - fm) < WGM ? (nM - fm) : WGM;
        u.pm = fm + ((wgid % nig) % gsz); u.pn = (wgid % nig) / gsz; return true;
    }
    __device__ __forceinline__ void a_ready(const Unit&) const {}
    __device__ __forceinline__ void done(const Unit&) const {}
};
struct SubOrder {
    StaticOrder S; int lo, hi;
    __host__ __device__ bool next(int i, Unit& u) const { return (lo + i < hi) && S.next(lo + i, u); }
    __device__ __forceinline__ void a_ready(const Unit&) const {}
    __device__ __forceinline__ void done(const Unit&) const {}
};
__device__ __forceinline__ unsigned cvt_pk_bf16(float lo, float hi) { unsigned r; asm volatile("v_cvt_pk_bf16_f32 %0, %1, %2" : "=v"(r) : "v"(lo), "v"(hi)); return r; }
__device__ __forceinline__ u32x4 pack8(const f32x4& v0, const f32x4& v1) { u32x4 w; w.x = cvt_pk_bf16(v0[0], v0[1]); w.y = cvt_pk_bf16(v0[2], v0[3]); w.z = cvt_pk_bf16(v1[0], v1[1]); w.w = cvt_pk_bf16(v1[2], v1[3]); return w; }
__device__ __forceinline__ void unpack8(const u32x4& w, f32x4& v0, f32x4& v1) { v0 = (f32x4){bflo(w.x), bfhi(w.x), bflo(w.y), bfhi(w.y)}; v1 = (f32x4){bflo(w.z), bfhi(w.z), bflo(w.w), bfhi(w.w)}; }

__device__ __forceinline__ float row_rstd(const float* rsq, const PG8_LAS float* tab, int pm0, int pm, int r) {
    if (pm == pm0) return tab[r];
    const f32x4* q = (const f32x4*)(rsq + (size_t)(pm * BM + r) * 32); float s = 0.f;
#pragma unroll
    for (int i = 0; i < 8; ++i) { const f32x4 v = q[i]; s += (v[0] + v[1]) + (v[2] + v[3]); }
    return rsqrtf(s * (1.f / D) + EPS);
}
struct EpiProj {
    static constexpr bool PERM = true, AFTER_DRAIN = false, RESCALE = false, TWICE = (MK_DUP == 31);
    bf16_t* PJ; const float* bg; float* vsq; const float* rsq; const PG8_LAS float* tab; int pm0;
    __device__ __forceinline__ void rescale(f32x4 (&)[2][2][4][2], const Unit&, int, int, int, int, int) const {}
    template <int KIND> __device__ __forceinline__ void run(const f32x4 (&acc)[2][2][4][2], const Unit& u, int wr, int wc, int fr, int fq) const {
        const int row0 = u.pm * BM + wr * 64 + fr, col0 = u.pn * BM + wc * 32 + 8 * fq;
        f32x4 bv[2][2];
        if (KIND == 4) {
#pragma unroll
            for (int bj = 0; bj < 2; ++bj)
#pragma unroll
                for (int n = 0; n < 2; ++n) bv[bj][n] = *(const f32x4*)(bg + (col0 - OFF_G) + bj * HALF + 4 * n);
        }
        unsigned char* pjb = (unsigned char*)PJ;
        float rs[2][4];
#pragma unroll
        for (int ai = 0; ai < 2; ++ai)
#pragma unroll
            for (int m = 0; m < 4; ++m) rs[ai][m] = row_rstd(rsq, tab, pm0, u.pm, wr * 64 + fr + ai * HALF + m * 16);
#pragma unroll
        for (int ai = 0; ai < 2; ++ai)
#pragma unroll
            for (int m = 0; m < 4; ++m) {
                const int row = row0 + ai * HALF + m * 16; float ss = 0.f;
#pragma unroll
                for (int bj = 0; bj < 2; ++bj) {
                    const int col = col0 + bj * HALF; bf16_t* dst;
                    if (KIND == 0) dst = (bf16_t*)(pjb + PJ_U) + (size_t)row * MW + col;
                    else if (KIND == 1) dst = (bf16_t*)(pjb + PJ_VG) + (size_t)row * MW + (col - OFF_V);
                    else if (KIND == 2) { const int c = col - OFF_S5; dst = (bf16_t*)(pjb + PJ_SIN) + ((size_t)((row >> 12) * 64 + (c >> 4)) * SEQ + (row & (SEQ - 1))) * 16 + (c & 15); }
                    else if (KIND == 3) { const int c = col - OFF_Q; dst = (bf16_t*)(pjb + PJ_Q + (size_t)(c >> 10) * (PJ_K - PJ_Q)) + ((size_t)((row >> 12) * 8 + ((c >> 7) & 7)) * SEQ + (row & (SEQ - 1))) * 128 + (c & 127); }
                    else dst = (bf16_t*)(pjb + PJ_GT) + (size_t)row * (3 * D) + (col - OFF_G);
                    f32x4 v0 = acc[ai][bj][m][0] * rs[ai][m], v1 = acc[ai][bj][m][1] * rs[ai][m];
                    if (KIND <= 1) {
#pragma unroll
                        for (int j = 0; j < 4; ++j) { v0[j] = gelu_t(v0[j]); v1[j] = gelu_t(v1[j]); }
                        if (KIND == 1) ss += (v0[0] * v0[0] + v0[1] * v0[1]) + (v0[2] * v0[2] + v0[3] * v0[3]) + (v1[0] * v1[0] + v1[1] * v1[1]) + (v1[2] * v1[2] + v1[3] * v1[3]);
                    } else if (KIND == 4) {
                        v0 = v0 + bv[bj][0]; v1 = v1 + bv[bj][1];
#pragma unroll
                        for (int j = 0; j < 4; ++j) { v0[j] = fmaxf(sigmoid_f(v0[j]), 1e-30f); v1[j] = fmaxf(sigmoid_f(v1[j]), 1e-30f); }
                    }
                    *(u32x4*)dst = pack8(v0, v1);
                }
                if (KIND == 1) { ss += __shfl_xor(ss, 16); ss += __shfl_xor(ss, 32); if (fq == 0) vsq[(size_t)row * 16 + (u.pn - 4) * 4 + wc] = ss; }
            }
    }
    __device__ __forceinline__ void operator()(const f32x4 (&acc)[2][2][4][2], const Unit& u, int wr, int wc, int fr, int fq) const {
        if (u.pn < 4) run<0>(acc, u, wr, wc, fr, fq);
        else if (u.pn < 8) run<1>(acc, u, wr, wc, fr, fq);
        else if (u.pn < 12) run<2>(acc, u, wr, wc, fr, fq);
        else if (u.pn < 24) run<3>(acc, u, wr, wc, fr, fq);
        else run<4>(acc, u, wr, wc, fr, fq);
    }
};
struct EpiGlu {
    static constexpr bool PERM = true, AFTER_DRAIN = false, RESCALE = false, TWICE = false;
    const bf16_t* G; const float* b; bf16_t* YS;
    __device__ __forceinline__ void rescale(f32x4 (&)[2][2][4][2], const Unit&, int, int, int, int, int) const {}
    __device__ __forceinline__ void operator()(const f32x4 (&acc)[2][2][4][2], const Unit& u, int wr, int wc, int fr, int fq) const {
        const int row0 = u.pm * BM + wr * 64 + fr, col0 = u.pn * BM + wc * 32 + 8 * fq;
        f32x4 bv[2][2];
#pragma unroll
        for (int bj = 0; bj < 2; ++bj)
#pragma unroll
            for (int n = 0; n < 2; ++n) bv[bj][n] = *(const f32x4*)(b + col0 + bj * HALF + 4 * n);
#pragma unroll
        for (int ai = 0; ai < 2; ++ai)
#pragma unroll
            for (int m = 0; m < 4; ++m) {
                const int row = row0 + ai * HALF + m * 16;
#pragma unroll
                for (int bj = 0; bj < 2; ++bj) {
                    f32x4 g0, g1; unpack8(*(const u32x4*)(G + (size_t)row * MW + col0 + bj * HALF), g0, g1);
                    f32x4 v0 = acc[ai][bj][m][0] + bv[bj][0], v1 = acc[ai][bj][m][1] + bv[bj][1];
#pragma unroll
                    for (int j = 0; j < 4; ++j) { v0[j] = g0[j] * sigmoid_f(v0[j]); v1[j] = g1[j] * sigmoid_f(v1[j]); }
                    *(u32x4*)(YS + (size_t)row * YSW + MW + col0 + bj * HALF) = pack8(v0, v1);
                }
            }
    }
};
struct EpiBranch {
    static constexpr bool PERM = true, AFTER_DRAIN = false, RESCALE = true, TWICE = false;
    const bf16_t* P; bf16_t* Mg;
    __device__ __forceinline__ void rescale(f32x4 (&acc)[2][2][4][2], const Unit& u, int seg, int wr, int wc, int fr, int fq) const {
        const int row0 = u.pm * BM + wr * 64 + fr, col0 = u.pn * BM + wc * 32 + 8 * fq;
#pragma unroll
        for (int ai = 0; ai < 2; ++ai)
#pragma unroll
            for (int mh = 0; mh < 2; ++mh) {
                u32x4 gp[2][2], gn[2][2];
#pragma unroll
                for (int mm = 0; mm < 2; ++mm)
#pragma unroll
                    for (int bj = 0; bj < 2; ++bj) { const bf16_t* q = P + (size_t)(row0 + ai * HALF + (2 * mh + mm) * 16) * (3 * D) + (seg - 1) * D + col0 + bj * HALF; gp[mm][bj] = *(const u32x4*)q; gn[mm][bj] = *(const u32x4*)(q + D); }
#pragma unroll
                for (int mm = 0; mm < 2; ++mm)
#pragma unroll
                    for (int bj = 0; bj < 2; ++bj) { const int m = 2 * mh + mm; f32x4 a0, a1, b0, b1; unpack8(gp[mm][bj], a0, a1); unpack8(gn[mm][bj], b0, b1);
#pragma unroll
                        for (int j = 0; j < 4; ++j) { acc[ai][bj][m][0][j] *= a0[j] * __builtin_amdgcn_rcpf(b0[j]); acc[ai][bj][m][1][j] *= a1[j] * __builtin_amdgcn_rcpf(b1[j]); } }
                asm volatile("" ::: "memory");
            }
    }
    __device__ __forceinline__ void operator()(const f32x4 (&acc)[2][2][4][2], const Unit& u, int wr, int wc, int fr, int fq) const {
        const int row0 = u.pm * BM + wr * 64 + fr, col0 = u.pn * BM + wc * 32 + 8 * fq;
#pragma unroll
        for (int ai = 0; ai < 2; ++ai)
#pragma unroll
            for (int m = 0; m < 4; ++m) {
                const int row = row0 + ai * HALF + m * 16;
#pragma unroll
                for (int bj = 0; bj < 2; ++bj) {
                    f32x4 g0, g1; unpack8(*(const u32x4*)(P + (size_t)row * (3 * D) + 2 * D + col0 + bj * HALF), g0, g1);
                    *(u32x4*)(Mg + (size_t)row * D + col0 + bj * HALF) = pack8(acc[ai][bj][m][0] * g0, acc[ai][bj][m][1] * g1);
                }
            }
    }
};
struct EpiResN {
    static constexpr bool PERM = true, AFTER_DRAIN = false, RESCALE = false, TWICE = false;
    const float* base32; const bf16_t* baseb; bf16_t* XB; float* X32; float* rsq;
    __device__ __forceinline__ void rescale(f32x4 (&)[2][2][4][2], const Unit&, int, int, int, int, int) const {}
    template <bool B32, bool O32> __device__ __forceinline__ void run(const f32x4 (&acc)[2][2][4][2], const Unit& u, int wr, int wc, int fr, int fq) const {
        const int row0 = u.pm * BM + wr * 64 + fr, col0 = u.pn * BM + wc * 32 + 8 * fq;
#pragma unroll
        for (int ai = 0; ai < 2; ++ai)
#pragma unroll
            for (int m = 0; m < 4; ++m) {
                const int row = row0 + ai * HALF + m * 16; const size_t off = (size_t)row * D + col0; float ss = 0.f;
#pragma unroll
                for (int bj = 0; bj < 2; ++bj) {
                    const size_t o = off + bj * HALF; f32x4 x0, x1;
                    if (B32) { x0 = *(const f32x4*)(base32 + o); x1 = *(const f32x4*)(base32 + o + 4); } else unpack8(*(const u32x4*)(baseb + o), x0, x1);
                    x0 = x0 + acc[ai][bj][m][0]; x1 = x1 + acc[ai][bj][m][1];
                    if (O32) { *(f32x4*)(X32 + o) = x0; *(f32x4*)(X32 + o + 4) = x1; }
                    ss += (x0[0] * x0[0] + x0[1] * x0[1]) + (x0[2] * x0[2] + x0[3] * x0[3]) + (x1[0] * x1[0] + x1[1] * x1[1]) + (x1[2] * x1[2] + x1[3] * x1[3]);
                    *(u32x4*)(XB + o) = pack8(x0, x1);
                }
                ss += __shfl_xor(ss, 16); ss += __shfl_xor(ss, 32);
                if (fq == 0) rsq[(size_t)row * 32 + u.pn * 4 + wc] = ss;
            }
    }
    __device__ __forceinline__ void operator()(const f32x4 (&acc)[2][2][4][2], const Unit& u, int wr, int wc, int fr, int fq) const {
        if (base32) run<true, false>(acc, u, wr, wc, fr, fq); else if (X32) run<false, true>(acc, u, wr, wc, fr, fq); else run<false, false>(acc, u, wr, wc, fr, fq);
    }
};
struct EpiRelu2 {
    static constexpr bool PERM = true, AFTER_DRAIN = false, RESCALE = false, TWICE = (MK_DUP == 38);
    bf16_t* Hd; const float* rsq; const PG8_LAS float* tab; int pm0;
    __device__ __forceinline__ void rescale(f32x4 (&)[2][2][4][2], const Unit&, int, int, int, int, int) const {}
    __device__ __forceinline__ void operator()(const f32x4 (&acc)[2][2][4][2], const Unit& u, int wr, int wc, int fr, int fq) const {
        const int row0 = u.pm * BM + wr * 64 + fr, col0 = u.pn * BM + wc * 32 + 8 * fq;
#pragma unroll
        for (int ai = 0; ai < 2; ++ai)
#pragma unroll
            for (int m = 0; m < 4; ++m) {
                bf16_t* rowp = Hd + (size_t)(row0 + ai * HALF + m * 16) * DFF + col0; const float rs = row_rstd(rsq, tab, pm0, u.pm, wr * 64 + fr + ai * HALF + m * 16);
#pragma unroll
                for (int bj = 0; bj < 2; ++bj) {
                    f32x4 v0 = acc[ai][bj][m][0] * rs, v1 = acc[ai][bj][m][1] * rs;
#pragma unroll
                    for (int j = 0; j < 4; ++j) { const float a = fmaxf(v0[j], 0.f), c = fmaxf(v1[j], 0.f); v0[j] = a * a; v1[j] = c * c; }
                    *(u32x4*)(rowp + bj * HALF) = pack8(v0, v1);
                }
            }
    }
};
template <class Epi, class Sched, bool ALIGN_EPI = false, bool SP2 = false>
__device__ __forceinline__ void gemm_phase(PG8_LAS unsigned char* lds, const Gemm g, const Sched& S, const Epi& E, const int tid_in) {
    int tid_l = tid_in; asm volatile("" : "+v"(tid_l));
    const int tid = tid_l, wid = __builtin_amdgcn_readfirstlane(tid >> 6), lane = tid & 63, wr = wid >> 2, wc = wid & 3, fr = lane & 15, fq = lane >> 4;
    const int K = g.K, nt = K / BK;
    unsigned voffA[2], voffB[2];
#pragma unroll
    for (int i = 0; i < 2; ++i) { int R, C; stage_rc(tid * 16 + i * 8192, R, C); const int Rb = Epi::PERM ? ((R & ~31) + perm32(R & 31)) : R;
        voffA[i] = (unsigned)(R * K + C) * 2u; voffB[i] = (unsigned)(Rb * K + C) * 2u; }
    const size_t kstep = (size_t)(BK * 2);
    const size_t hstep = (size_t)HALF * K * 2;
    const size_t tstep = 2 * hstep;
    const unsigned ldsw = (unsigned)wid * 1024u;
    const int aoff = lds_byte(wr * 64 + fr, fq * 8), boff = lds_byte(wc * 32 + fr, fq * 8);
#define PG8_SA(b, h) (((b) * 2 + (h)) * HTB)
#define PG8_SB(b, h) ((4 + (b) * 2 + (h)) * HTB)
#define PG8_STAGE(bufoff, gbase, voff) do { _Pragma("unroll") for (int _i = 0; _i < 2; ++_i) \
        __builtin_amdgcn_global_load_lds((const unsigned*)((const char*)(gbase) + (voff)[_i]), (PG8_LAS unsigned*)(lds + (bufoff) + ldsw + _i * 8192), 16, 0, 0); } while (0)
#define PG8_LDA(dst, b, h) do { _Pragma("unroll") for (int m = 0; m < 4; ++m) _Pragma("unroll") for (int k = 0; k < 2; ++k) dst[m][k] = *(const PG8_LAS bf16x8*)(lds + PG8_SA(b, h) + aoff + m * 2048 + k * 1024); } while (0)
#define PG8_LDB(dst, b, h) do { _Pragma("unroll") for (int n = 0; n < 2; ++n) _Pragma("unroll") for (int k = 0; k < 2; ++k) dst[n][k] = *(const PG8_LAS bf16x8*)(lds + PG8_SB(b, h) + boff + n * 2048 + k * 1024); } while (0)
#define PG8_MMA(ai, bj, At, Bt) do { __builtin_amdgcn_s_setprio(1); _Pragma("unroll") for (int m = 0; m < 4; ++m) _Pragma("unroll") for (int n = 0; n < 2; ++n) _Pragma("unroll") for (int k = 0; k < 2; ++k) \
        acc[ai][bj][m][n] = __builtin_amdgcn_mfma_f32_16x16x32_bf16(Bt[n][k], At[m][k], acc[ai][bj][m][n], 0, 0, 0); __builtin_amdgcn_s_setprio(0); } while (0)
#define PG8_WAIT_V(n) asm volatile("s_waitcnt vmcnt(" #n ")" ::: "memory")
#define PG8_WAIT_L(n) asm volatile("s_waitcnt lgkmcnt(" #n ")" ::: "memory")
#define PG8_BAR __builtin_amdgcn_s_barrier()
#define PG8_SCHED __builtin_amdgcn_sched_barrier(0)
    Unit cur, nxt; int ui = 0;
    if (!S.next(0, cur)) return;
    f32x4 acc[2][2][4][2];
#pragma unroll
    for (int a = 0; a < 2; ++a)
#pragma unroll
        for (int b = 0; b < 2; ++b)
#pragma unroll
            for (int m = 0; m < 4; ++m)
#pragma unroll
                for (int n = 0; n < 2; ++n) acc[a][b][m][n] = (f32x4){0.f, 0.f, 0.f, 0.f};
    bf16x8 At[4][2], B0[2][2], B1[2][2];
    const char* cA = (const char*)g.A + (size_t)cur.pm * tstep; const char* cB = (const char*)g.Bt + (size_t)cur.pn * tstep;
    S.a_ready(cur);
    if constexpr (SP2) {
        PG8_STAGE(PG8_SB(0, 0), cB, voffB); PG8_STAGE(PG8_SB(0, 1), cB + hstep, voffB); PG8_STAGE(PG8_SA(0, 0), cA, voffA); PG8_STAGE(PG8_SA(0, 1), cA + hstep, voffA);
        if (wr == 1) PG8_BAR;
        PG8_WAIT_V(2); PG8_BAR;
        PG8_STAGE(PG8_SB(1, 0), cB + kstep, voffB); PG8_STAGE(PG8_SA(1, 0), cA + kstep, voffA); PG8_STAGE(PG8_SB(1, 1), cB + hstep + kstep, voffB);
        PG8_WAIT_V(6); PG8_BAR;
    } else {
        PG8_STAGE(PG8_SB(0, 0), cB, voffB); PG8_STAGE(PG8_SA(0, 0), cA, voffA); PG8_STAGE(PG8_SB(0, 1), cB + hstep, voffB); PG8_STAGE(PG8_SA(0, 1), cA + hstep, voffA);
        if (wr == 1) PG8_BAR;
        PG8_WAIT_V(4); PG8_BAR;
        PG8_STAGE(PG8_SB(1, 0), cB + kstep, voffB); PG8_STAGE(PG8_SA(1, 0), cA + kstep, voffA); PG8_STAGE(PG8_SB(1, 1), cB + hstep + kstep, voffB);
        PG8_WAIT_V(6); PG8_BAR;
    }
    for (;;) {
        const bool has_next = S.next(ui + 1, nxt);
        const char* nA = has_next ? (const char*)g.A + (size_t)nxt.pm * tstep : cA; const char* nB = has_next ? (const char*)g.Bt + (size_t)nxt.pn * tstep : cB;
        for (int t = 0; t < nt; t += 2) {
            const bool last = (t == nt - 2);
            const char* a1 = cA + (size_t)(t + 1) * kstep;
            const char* a2 = last ? nA : cA + (size_t)(t + 2) * kstep; const char* b2 = last ? nB : cB + (size_t)(t + 2) * kstep;
            const char* a3 = a2 + kstep; const char* b3 = b2 + kstep;
            if (last && has_next) S.a_ready(nxt);
            if constexpr (SP2) {
            PG8_LDB(B0, 0, 0); PG8_LDB(B1, 0, 1); PG8_SCHED; PG8_LDA(At, 0, 0); PG8_STAGE(PG8_SA(1, 1), a1 + hstep, voffA);
            PG8_WAIT_V(8); PG8_WAIT_L(0); PG8_BAR; PG8_MMA(0, 0, At, B0); PG8_MMA(0, 1, At, B1); PG8_BAR; PG8_SCHED;
            PG8_LDA(At, 0, 1); PG8_STAGE(PG8_SB(0, 0), b2, voffB); PG8_STAGE(PG8_SB(0, 1), b2 + hstep, voffB); PG8_STAGE(PG8_SA(0, 0), a2, voffA);
            PG8_WAIT_V(8); PG8_WAIT_L(0); PG8_BAR; PG8_MMA(1, 0, At, B0); PG8_MMA(1, 1, At, B1); PG8_BAR; PG8_SCHED;
            PG8_LDB(B0, 1, 0); PG8_LDB(B1, 1, 1); PG8_SCHED; PG8_LDA(At, 1, 0); PG8_STAGE(PG8_SA(0, 1), a2 + hstep, voffA);
            PG8_WAIT_V(8); PG8_WAIT_L(0); PG8_BAR; PG8_MMA(0, 0, At, B0); PG8_MMA(0, 1, At, B1); PG8_BAR; PG8_SCHED;
            PG8_LDA(At, 1, 1); PG8_STAGE(PG8_SB(1, 0), b3, voffB); PG8_STAGE(PG8_SB(1, 1), b3 + hstep, voffB); PG8_STAGE(PG8_SA(1, 0), a3, voffA);
            PG8_WAIT_V(8); PG8_WAIT_L(0); PG8_BAR; PG8_MMA(1, 0, At, B0); PG8_MMA(1, 1, At, B1); PG8_BAR; PG8_SCHED;
            } else {
            PG8_LDB(B0, 0, 0); PG8_SCHED; PG8_LDA(At, 0, 0); PG8_STAGE(PG8_SA(1, 1), a1 + hstep, voffA);
            PG8_WAIT_L(8); PG8_BAR; PG8_WAIT_L(0); PG8_MMA(0, 0, At, B0); PG8_BAR; PG8_SCHED;
            PG8_LDB(B1, 0, 1); PG8_STAGE(PG8_SB(0, 0), b2, voffB);
            PG8_BAR; PG8_WAIT_L(0); PG8_MMA(0, 1, At, B1); PG8_BAR;
            PG8_LDA(At, 0, 1); PG8_STAGE(PG8_SA(0, 0), a2, voffA);
            PG8_BAR; PG8_WAIT_L(0); PG8_MMA(1, 0, At, B0); PG8_BAR; PG8_SCHED;
            PG8_STAGE(PG8_SB(0, 1), b2 + hstep, voffB);
            PG8_WAIT_V(6); PG8_BAR; PG8_MMA(1, 1, At, B1); PG8_BAR;
            PG8_LDB(B0, 1, 0); PG8_SCHED; PG8_LDA(At, 1, 0); PG8_STAGE(PG8_SA(0, 1), a2 + hstep, voffA);
            PG8_WAIT_L(8); PG8_BAR; PG8_WAIT_L(0); PG8_MMA(0, 0, At, B0); PG8_BAR; PG8_SCHED;
            PG8_LDB(B1, 1, 1); PG8_STAGE(PG8_SB(1, 0), b3, voffB);
            PG8_BAR; PG8_WAIT_L(0); PG8_MMA(0, 1, At, B1); PG8_BAR;
            PG8_LDA(At, 1, 1); PG8_STAGE(PG8_SA(1, 0), a3, voffA);
            PG8_BAR; PG8_WAIT_L(0); PG8_MMA(1, 0, At, B0); PG8_BAR; PG8_SCHED;
            PG8_STAGE(PG8_SB(1, 1), b3 + hstep, voffB);
            PG8_WAIT_V(6); PG8_BAR; PG8_MMA(1, 1, At, B1); PG8_BAR;
            }
            if constexpr (Epi::RESCALE) { if ((((t + 2) & 15) == 0) && (t + 2 < nt)) E.rescale(acc, cur, (t + 2) >> 4, wr, wc, fr, fq); }
        }
        if constexpr (ALIGN_EPI) { if (wr == 0) PG8_BAR; }
        if constexpr (!Epi::AFTER_DRAIN) { E(acc, cur, wr, wc, fr, fq); if constexpr (Epi::TWICE) { asm volatile("" ::: "memory"); E(acc, cur, wr, wc, fr, fq); } S.done(cur); }
        if (!has_next) break;
#pragma unroll
        for (int a = 0; a < 2; ++a)
#pragma unroll
            for (int b = 0; b < 2; ++b)
#pragma unroll
                for (int m = 0; m < 4; ++m)
#pragma unroll
                    for (int n = 0; n < 2; ++n) acc[a][b][m][n] = (f32x4){0.f, 0.f, 0.f, 0.f};
        cur = nxt; cA = nA; cB = nB; ++ui;
        if constexpr (ALIGN_EPI) { if (wr == 1) PG8_BAR; }
    }
    PG8_WAIT_V(0);
    if constexpr (!ALIGN_EPI) { if (wr == 0) PG8_BAR; }
    PG8_BAR;
    if constexpr (Epi::AFTER_DRAIN) { E.fused(acc, cur, wr, wc, fr, fq, lds, wid, lane); S.done(cur); }
#undef PG8_SA
#undef PG8_SB
#undef PG8_STAGE
#undef PG8_LDA
#undef PG8_LDB
#undef PG8_MMA
#undef PG8_WAIT_V
#undef PG8_WAIT_L
#undef PG8_BAR
#undef PG8_SCHED
}
}
#define XB_TMO      128
#define XB_XCNT(j)  (256  + 64 * (j))
#define XB_XSUB(j)  (1280 + 64 * (j))
#define XB_XGEN(j)  (2304 + 64 * (j))
#define XB_TOP      3328
#define XB_TOPGEN   3392
#define XCD_BAR_WORDS 3456
#define XB_SPIN_CAP (1u << 18)
#define LAS __attribute__((address_space(3)))

__device__ __forceinline__ unsigned xb_ld(unsigned* p)              { return __hip_atomic_load(p, __ATOMIC_RELAXED, __HIP_MEMORY_SCOPE_AGENT); }
__device__ __forceinline__ unsigned xb_add(unsigned* p, unsigned v) { return __hip_atomic_fetch_add(p, v, __ATOMIC_RELAXED, __HIP_MEMORY_SCOPE_AGENT); }
__device__ __forceinline__ unsigned xb_xcc_id() { return (unsigned)__builtin_amdgcn_s_getreg((3 << 11) | 20) & 0xFu; }
#define XB_SPIN(cond, bar) do { unsigned _sp = 0; while (cond) { __builtin_amdgcn_s_sleep(1); \
    if ((++_sp & 255u) == 0u) { if (xb_ld(&(bar)[XB_TMO])) break; if (_sp > XB_SPIN_CAP) { atomicAdd(&(bar)[XB_TMO], 1u); break; } } } } while (0)

struct XcdBarrier {
    unsigned* bar; unsigned x;
    volatile LAS unsigned* st;
};

__device__ __forceinline__ XcdBarrier xcd_barrier_post(unsigned* bar, volatile LAS unsigned* st) {
    XcdBarrier b; b.bar = bar; b.x = xb_xcc_id(); b.st = st;
    if (threadIdx.x == 0) (void)xb_add(&bar[XB_XCNT(b.x)], 1u);
    return b;
}
__device__ __forceinline__ void xcd_barrier_complete(unsigned* bar, unsigned x, unsigned& nloc, unsigned& nx) {
    const unsigned G = gridDim.x * gridDim.y * gridDim.z;
    unsigned sum, cnt, mine, sp = 0u;
    for (;;) {
        sum = 0u; cnt = 0u; mine = 0u;
#pragma unroll
        for (unsigned j = 0; j < 16; ++j) { const unsigned c = xb_ld(&bar[XB_XCNT(j)]); sum += c; cnt += (c > 0u) ? 1u : 0u; mine = (j == x) ? c : mine; }
        if (sum == G) break;
        __builtin_amdgcn_s_sleep(1);
        if ((++sp & 255u) == 0u) { if (xb_ld(&bar[XB_TMO])) break; if (sp > XB_SPIN_CAP) { atomicAdd(&bar[XB_TMO], 1u); break; } }
    }
    nloc = mine > 0u ? mine : 1u; nx = cnt > 0u ? cnt : 1u;
}

__device__ __forceinline__ void xcd_barrier(const XcdBarrier& b, const bool t0  ) {
    asm volatile("s_waitcnt vmcnt(0)" ::: "memory");
    __syncthreads();
    if (t0) {
        unsigned* bar = b.bar;
        __builtin_amdgcn_s_waitcnt(0);
        unsigned nloc = b.st[0], nx = b.st[1];
        if (nloc == 0u) { xcd_barrier_complete(bar, b.x, nloc, nx); b.st[0] = nloc; b.st[1] = nx; }
        const unsigned old = xb_add(&bar[XB_XSUB(b.x)], 1u);
        const unsigned gen = old / nloc;
        if (old + 1u == (gen + 1u) * nloc) {
            __builtin_amdgcn_fence(__ATOMIC_RELEASE, "agent");
            asm volatile("s_waitcnt vmcnt(0)" ::: "memory");
            const unsigned og = xb_add(&bar[XB_TOP], 1u);
            const unsigned tg = og / nx;
            if (og + 1u == (tg + 1u) * nx) xb_add(&bar[XB_TOPGEN], 1u);
            else XB_SPIN(xb_ld(&bar[XB_TOPGEN]) == tg, bar);
            __builtin_amdgcn_fence(__ATOMIC_ACQUIRE, "agent");
            xb_add(&bar[XB_XGEN(b.x)], 1u);
            asm volatile("s_waitcnt vmcnt(0)" ::: "memory");
        } else {
            XB_SPIN(xb_ld(&bar[XB_XGEN(b.x)]) == gen, bar);
            __builtin_amdgcn_fence(__ATOMIC_ACQUIRE, "agent");
            asm volatile("s_waitcnt vmcnt(0)" ::: "memory");
        }
    }
    __syncthreads();
}
constexpr int NWAVES = 8, NTHR = 512;
constexpr int LDS_CTL_OFF = 139264;
constexpr int LDS_BYTES = 147456;
#define MFMA16(a, b, c) __builtin_amdgcn_mfma_f32_16x16x32_bf16((a), (b), (c), 0, 0, 0)
#define MFMA32(a, b, c) __builtin_amdgcn_mfma_f32_32x32x16_bf16((a), (b), (c), 0, 0, 0)
typedef short s16x4 __attribute__((ext_vector_type(4)));
__device__ __forceinline__ void lds_barrier() { asm volatile("s_waitcnt lgkmcnt(0)" ::: "memory"); __builtin_amdgcn_s_barrier(); asm volatile("" ::: "memory"); }
__device__ __forceinline__ int crow(int reg, int h) { return (reg & 3) + 8 * (reg >> 2) + 4 * h; }

__device__ __forceinline__ void tr_tile(const float* W, int N, bf16* WT, int ldo, int koff, LAS float* scr  , int k0, int n0, int lane, const float* gk = nullptr  ) {
    float v[64];
#pragma unroll
    for (int kk = 0; kk < 64; ++kk) v[kk] = __builtin_nontemporal_load(W + (size_t)(k0 + kk) * N + n0 + lane);
    if (gk) {
#pragma unroll
        for (int kk = 0; kk < 64; ++kk) v[kk] *= gk[k0 + kk];
    }
#pragma unroll
    for (int kk = 0; kk < 64; ++kk) scr[kk * 65 + lane] = v[kk];
    asm volatile("s_waitcnt lgkmcnt(0)" ::: "memory");
    const int c = lane & 7;
#pragma unroll
    for (int j = 0; j < 8; ++j) {
        const int n = (lane >> 3) + 8 * j; const LAS float* s = scr + (8 * c) * 65 + n;
        u32x4 o; o.x = pk2(s[0], s[65]); o.y = pk2(s[2 * 65], s[3 * 65]); o.z = pk2(s[4 * 65], s[5 * 65]); o.w = pk2(s[6 * 65], s[7 * 65]);
        *(u32x4*)(WT + (size_t)(n0 + n) * ldo + koff + k0 + 8 * c) = o;
    }
    asm volatile("s_waitcnt lgkmcnt(0)" ::: "memory");
}
struct ConvSrc { const float *w_in, *w_glu, *w_branch, *w_out, *w_mi, *w_mo, *g1, *g2; };
constexpr int CV_T_IN = 32 * 192, CV_T_GLU = 16 * 16, CV_T_BR = 3 * 16 * 32, CV_T_OUT = 32 * 32, CV_T_MI = 32 * 128, CV_T_MO = 128 * 32, CV_TL = CV_T_IN + CV_T_GLU + CV_T_BR + CV_T_OUT + CV_T_MI + CV_T_MO;
constexpr int CV_LATE = 7424;
__device__ __forceinline__ void conv_tile(const ConvSrc& S, unsigned char* ws, LAS float* scr, int l, int r, int lane) {
    unsigned char* wl = ws + WS_W + (size_t)l * WL_SIZE;
    if (r < CV_T_IN) { tr_tile(S.w_in + (size_t)l * D * PC, PC, (bf16*)(wl + WL_IN), D, 0, scr, (r / 192) * 64, (r % 192) * 64, lane, S.g1 + (size_t)l * D); return; } r -= CV_T_IN;
    if (r < CV_T_GLU) { tr_tile(S.w_glu + (size_t)l * MW * MW, MW, (bf16*)(wl + WL_GLU), MW, 0, scr, (r / 16) * 64, (r % 16) * 64, lane); return; } r -= CV_T_GLU;
    if (r < CV_T_BR) { const int n3 = r / 512, rr = r % 512; tr_tile(S.w_branch + ((size_t)l * 3 + n3) * MW * D, D, (bf16*)(wl + WL_BR), 3 * MW, n3 * MW, scr, (rr / 32) * 64, (rr % 32) * 64, lane); return; } r -= CV_T_BR;
    if (r < CV_T_OUT) { tr_tile(S.w_out + (size_t)l * D * D, D, (bf16*)(wl + WL_OUT), D, 0, scr, (r / 32) * 64, (r % 32) * 64, lane); return; } r -= CV_T_OUT;
    if (r < CV_T_MI) { tr_tile(S.w_mi + (size_t)l * D * DFF, DFF, (bf16*)(wl + WL_MI), D, 0, scr, (r / 128) * 64, (r % 128) * 64, lane, S.g2 + (size_t)l * D); return; } r -= CV_T_MI;
    tr_tile(S.w_mo + (size_t)l * DFF * D, D, (bf16*)(wl + WL_MO), DFF, 0, scr, (r / 32) * 64, (r % 32) * 64, lane);
}
__device__ __forceinline__ void phase_conv(const ConvSrc& S, unsigned char* ws, LAS unsigned char* lds, int gw, int ngw, int wave, int lane, int lo0, int hi0, int late) {
    LAS float* scr = (LAS float*)(lds + wave * 16640);
    const int n0 = hi0 - lo0, per = CV_TL - late, total = n0 + (DEPTH - 1) * per;
    for (int it = gw; it < total; it += ngw) {
        if (it < n0) conv_tile(S, ws, scr, 0, lo0 + it, lane);
        else { const int j = it - n0; conv_tile(S, ws, scr, 1 + j / per, late + j % per, lane); }
    }
}
__device__ __forceinline__ void phase_conv_late(const ConvSrc& S, unsigned char* ws, LAS unsigned char* lds, int l, int iw, int nw, int wave, int lane, int late) {
    LAS float* scr = (LAS float*)(lds + wave * 16640);
    for (int it = iw; it < late; it += nw) conv_tile(S, ws, scr, l, it, lane);
}

struct S5Src { const float *lre, *lim, *ldt, *bre, *bim, *cre, *cim, *dd; };
__device__ __forceinline__ void phase_s5prep(const S5Src& S, unsigned char* ws, LAS unsigned char* lds, int tid) {
    LAS f32x2* pw = (LAS f32x2*)(lds);
    LAS f32x2* Bb = (LAS f32x2*)(lds + 8704);
    LAS f32x2* Cc = (LAS f32x2*)(lds + 16896);
    LAS float* Km = (LAS float*)(lds + 25088);
    for (int item = blockIdx.x; item < DEPTH * 64; item += gridDim.x) {
        const int l = item >> 6, g = item & 63; unsigned char* wl = ws + WS_W + (size_t)l * WL_SIZE;
        bf16* Wst = (bf16*)(wl + WL_WST) + (size_t)g * 128 * 256; bf16* W2 = (bf16*)(wl + WL_W2) + (size_t)g * 256 * 384; float2* A16 = (float2*)(wl + WL_A16) + g * 64;
        __syncthreads();
        if (tid < 64) {
            const int p = tid; const float dt = expf(S.ldt[l * 64 + g]); const float lr = S.lre[(l * 64 + g) * 64 + p], li = S.lim[(l * 64 + g) * 64 + p];
            const float mag = expf(lr * dt); float sn, cs; sincosf(li * dt, &sn, &cs);
            const float ar = mag * cs, ai = mag * sn; const float den = lr * lr + li * li; const float nr = ar - 1.f, ni = ai;
            const float kr = (nr * lr + ni * li) / den, ki = (ni * lr - nr * li) / den;
            float xr = 1.f, xi = 0.f; pw[p] = (f32x2){1.f, 0.f};
            for (int m = 1; m <= 16; ++m) { const float tr = xr * ar - xi * ai, ti = xr * ai + xi * ar; xr = tr; xi = ti; pw[m * 64 + p] = (f32x2){xr, xi}; }
            for (int h = 0; h < 16; ++h) { const float x = S.bre[((size_t)(l * 64 + g) * 64 + p) * 16 + h], y = S.bim[((size_t)(l * 64 + g) * 64 + p) * 16 + h]; Bb[p * 16 + h] = (f32x2){kr * x - ki * y, kr * y + ki * x}; }
        } else {
            for (int e = tid - 64; e < 1024; e += NTHR - 64) Cc[e] = (f32x2){S.cre[(size_t)(l * 64 + g) * 1024 + e], S.cim[(size_t)(l * 64 + g) * 1024 + e]};
        }
        __syncthreads();
        for (int e = tid; e < 4096; e += NTHR) {
            const int m = e >> 8, hp = (e >> 4) & 15, h = e & 15; float s = 0.f;
            for (int p = 0; p < 64; ++p) { const f32x2 c = Cc[hp * 64 + p], a = pw[m * 64 + p], b = Bb[p * 16 + h]; const float cr = c.x * a.x - c.y * a.y, ci = c.x * a.y + c.y * a.x; s += cr * b.x - ci * b.y; }
            Km[e] = s + ((m == 0 && hp == h) ? S.dd[l * MW + g * 16 + h] : 0.f);
        }
        __syncthreads();
        for (int e = tid; e < 128 * 256; e += NTHR) {
            const int o = e >> 8, k = e & 255, i = k >> 4, h = k & 15, p = o & 63; const f32x2 a = pw[(15 - i) * 64 + p], b = Bb[p * 16 + h];
            Wst[e] = f2bf(o < 64 ? a.x * b.x - a.y * b.y : a.x * b.y + a.y * b.x);
        }
        for (int e = tid; e < 256 * 384; e += NTHR) {
            const int o = e / 384, k = e % 384, j = o >> 4, hp = o & 15; float v;
            if (k < 256) { const int i = k >> 4, h = k & 15; v = (j >= i) ? Km[((j - i) * 16 + hp) * 16 + h] : 0.f; }
            else { const int p = (k - 256) & 63; const f32x2 c = Cc[hp * 64 + p], a = pw[(j + 1) * 64 + p]; v = (k < 320) ? (c.x * a.x - c.y * a.y) : -(c.x * a.y + c.y * a.x); }
            W2[e] = f2bf(v);
        }
        if (tid < 64) { const f32x2 q = pw[16 * 64 + tid]; A16[tid] = make_float2(q.x, q.y); }
    }
}

__device__ __forceinline__ void phase_rmsnorm_bf16(const float* x, const float* g, bf16* out, int gw, int ngw, int lane) {
    for (int row = gw; row < M; row += ngw) {
        const f32x4* xr = (const f32x4*)(x + (size_t)row * D) + lane; f32x4 v[8]; float s = 0.f;
#pragma unroll
        for (int j = 0; j < 8; ++j) { v[j] = xr[64 * j]; s += (v[j].x * v[j].x + v[j].y * v[j].y) + (v[j].z * v[j].z + v[j].w * v[j].w); }
        const float rstd = rsqrtf(wave_sum(s) * (1.f / D) + EPS);
        const f32x4* gr = (const f32x4*)g + lane; u32x2* o = (u32x2*)(out + (size_t)row * D) + lane;
#pragma unroll
        for (int j = 0; j < 8; ++j) { const f32x4 gg = gr[64 * j]; u32x2 w; w.x = pk2(v[j].x * rstd * gg.x, v[j].y * rstd * gg.y); w.y = pk2(v[j].z * rstd * gg.z, v[j].w * rstd * gg.w); o[64 * j] = w; }
    }
}
__device__ __forceinline__ void rstd_table(const float* rsq, int pm, LAS float* tab, int tid) {
    const f32x4* q = (const f32x4*)(rsq + (size_t)(pm * 256 + (tid >> 1)) * 32 + 16 * (tid & 1)); float s = 0.f;
#pragma unroll
    for (int i = 0; i < 4; ++i) { const f32x4 v = q[i]; s += (v[0] + v[1]) + (v[2] + v[3]); }
    s += __shfl_xor(s, 1);
    if (!(tid & 1)) tab[tid >> 1] = rsqrtf(s * (1.f / D) + EPS);
}
__device__ __forceinline__ void phase_norm0(const float* x, bf16* out, float* rsq, int gw, int ngw, int lane) {
    for (int row = gw; row < M; row += ngw) {
        const f32x4* xr = (const f32x4*)(x + (size_t)row * D) + lane; f32x4 v[8]; float s = 0.f;
#pragma unroll
        for (int j = 0; j < 8; ++j) { v[j] = xr[64 * j]; s += (v[j].x * v[j].x + v[j].y * v[j].y) + (v[j].z * v[j].z + v[j].w * v[j].w); }
        s = wave_sum(s); if (lane < 32) rsq[(size_t)row * 32 + lane] = lane == 0 ? s : 0.f;
        u32x2* o = (u32x2*)(out + (size_t)row * D) + lane;
#pragma unroll
        for (int j = 0; j < 8; ++j) { u32x2 w; w.x = pk2(v[j].x, v[j].y); w.y = pk2(v[j].z, v[j].w); o[64 * j] = w; }
    }
}
__device__ __forceinline__ void phase_rmsnorm_f32(const float* x, const float* g, float* out, int gw, int ngw, int lane) {
    for (int row = gw; row < M; row += ngw) {
        const f32x4* xr = (const f32x4*)(x + (size_t)row * D) + lane; f32x4 v[8]; float s = 0.f;
#pragma unroll
        for (int j = 0; j < 8; ++j) { v[j] = xr[64 * j]; s += (v[j].x * v[j].x + v[j].y * v[j].y) + (v[j].z * v[j].z + v[j].w * v[j].w); }
        const float rstd = rsqrtf(wave_sum(s) * (1.f / D) + EPS);
        const f32x4* gr = (const f32x4*)g + lane; f32x4* o = (f32x4*)(out + (size_t)row * D) + lane;
#pragma unroll
        for (int j = 0; j < 8; ++j) { const f32x4 gg = gr[64 * j]; o[64 * j] = (f32x4){v[j].x * rstd * gg.x, v[j].y * rstd * gg.y, v[j].z * rstd * gg.z, v[j].w * rstd * gg.w}; }
    }
}

constexpr int GM_VP = 160;
__device__ __forceinline__ void stage_gmlp(const bf16* U, const bf16* VG, const float* vsq, const float* gng, const float* wsl, const float* bsl, bf16* YS, LAS unsigned char* lds, int unit, int tid, int wave, int lane) {
    const int c = unit >> 3, g = unit & 7, row0 = c * 128;
    LAS float* rs = (LAS float*)lds;
    LAS bf16* Vt = (LAS bf16*)(lds + 512);
    lds_barrier();
    if (tid < 128) { const f32x4* q = (const f32x4*)(vsq + (size_t)(row0 + tid) * 16); const f32x4 a = q[0], b = q[1], cc = q[2], d = q[3];
        const float s = ((a.x + a.y) + (a.z + a.w)) + ((b.x + b.y) + (b.z + b.w)) + ((cc.x + cc.y) + (cc.z + cc.w)) + ((d.x + d.y) + (d.z + d.w)); rs[tid] = rsqrtf(s * (1.f / MW) + EPS); }
#pragma unroll
    for (int i = 0; i < 4; ++i) { const int idx = tid + NTHR * i, s = idx >> 4, cc = idx & 15; const u32x4 v = *(const u32x4*)(VG + (size_t)(row0 + s) * MW + g * 128 + 8 * cc); *(LAS u32x4*)(Vt + s * GM_VP + 8 * cc) = v; }
    lds_barrier();
    const int tq = wave >> 1, chh = wave & 1, r = lane & 31, hh = lane >> 5, t0 = 32 * tq, t = t0 + r;
    const int trl = ((lane & 15) >> 2) * GM_VP + 16 * ((lane >> 4) & 1) + 4 * (lane & 3);
    f32x16 acc[2];
#pragma unroll
    for (int i = 0; i < 16; ++i) { acc[0][i] = 0.f; acc[1][i] = 0.f; }
    for (int ks = 0; ks <= 2 * tq + 1; ++ks) {
        const int sb = 16 * ks + 8 * hh;
        const float* wp = wsl + (size_t)(g * 128 + t) * 128 + sb; const f32x4 w0 = *(const f32x4*)wp, w1 = *(const f32x4*)(wp + 4);
        const f32x4 r0 = *(const LAS f32x4*)(rs + sb), r1 = *(const LAS f32x4*)(rs + sb + 4);
        const float av[8] = {w0.x * r0.x, w0.y * r0.y, w0.z * r0.z, w0.w * r0.w, w1.x * r1.x, w1.y * r1.y, w1.z * r1.z, w1.w * r1.w};
        u32x4 bp;
#pragma unroll
        for (int j = 0; j < 4; ++j) { const float lo = (sb + 2 * j <= t) ? av[2 * j] : 0.f, hi = (sb + 2 * j + 1 <= t) ? av[2 * j + 1] : 0.f; bp[j] = pk2(lo, hi); }
        const bf16x8 bfrag = __builtin_bit_cast(bf16x8, bp);
#pragma unroll
        for (int ct = 0; ct < 2; ++ct) {
            const LAS bf16* vb = Vt + sb * GM_VP + 64 * chh + 32 * ct + trl;
            const s16x4 lo = __builtin_amdgcn_ds_read_tr16_b64_v4i16((LAS s16x4*)vb), hi = __builtin_amdgcn_ds_read_tr16_b64_v4i16((LAS s16x4*)(vb + 4 * GM_VP));
            acc[ct] = MFMA32(__builtin_shufflevector(lo, hi, 0, 1, 2, 3, 4, 5, 6, 7), bfrag, acc[ct]);
        }
    }
    const float bt = bsl[g * 128 + t];
#pragma unroll
    for (int ct = 0; ct < 2; ++ct)
#pragma unroll
        for (int gi = 0; gi < 4; ++gi) {
            const int ch = g * 128 + 64 * chh + 32 * ct + 8 * gi + 4 * hh; const f32x4 gn = *(const f32x4*)(gng + ch);
            const u32x2 uu = *(const u32x2*)(U + (size_t)(row0 + t) * MW + ch);
            u32x2 o; o.x = pk2(bflo(uu.x) * (gn[0] * acc[ct][4 * gi] + bt), bfhi(uu.x) * (gn[1] * acc[ct][4 * gi + 1] + bt)); o.y = pk2(bflo(uu.y) * (gn[2] * acc[ct][4 * gi + 2] + bt), bfhi(uu.y) * (gn[3] * acc[ct][4 * gi + 3] + bt));
            *(u32x2*)(YS + (size_t)(row0 + t) * YSW + ch) = o;
        }
}

constexpr int S5_PITCH = 784, S5_IMG_BYTES = 64 * S5_PITCH, S5_SL_OFF = 51200;
__device__ __forceinline__ void stage_s5(const bf16* SIN, const bf16* Wst_l, const bf16* W2_l, const float2* A16_l, bf16* G, LAS unsigned char* lds, int unit, int tid, int wave, int lane) {
    const int b = unit >> 6, g = unit & 63, fr = lane & 15, fq = lane >> 4;
    LAS unsigned char* img = lds; LAS float* Sl = (LAS float*)(lds + S5_SL_OFF);
    const bf16* wst = Wst_l + (size_t)g * 128 * 256; const bf16* w2 = W2_l + (size_t)g * 256 * 384;
    const bf16* uin = SIN + (size_t)(b * 64 + g) * SEQ * 16;
    bf16x8 wstf[8], w2f[2][12];
#pragma unroll
    for (int ks = 0; ks < 8; ++ks) wstf[ks] = *(const bf16x8*)(wst + (size_t)(16 * wave + fr) * 256 + 32 * ks + 8 * fq);
#pragma unroll
    for (int c2 = 0; c2 < 2; ++c2)
#pragma unroll
        for (int ks = 0; ks < 12; ++ks) w2f[c2][ks] = *(const bf16x8*)(w2 + (size_t)(16 * (2 * wave + c2) + fr) * 384 + 32 * ks + 8 * fq);
    const float2 a16 = A16_l[g * 64 + lane]; float sr = 0.f, si = 0.f;
    u32x4 ur[4];
#pragma unroll
    for (int i = 0; i < 4; ++i) ur[i] = *(const u32x4*)(uin + (size_t)(tid + NTHR * i) * 8);
    for (int q = 0; q < 4; ++q) {
        lds_barrier();
#pragma unroll
        for (int i = 0; i < 4; ++i) { const int idx = tid + NTHR * i; *(LAS u32x4*)(img + (idx >> 5) * S5_PITCH + (idx & 31) * 16) = ur[i]; }
        if (q < 3) {
#pragma unroll
            for (int i = 0; i < 4; ++i) ur[i] = *(const u32x4*)(uin + (size_t)(q + 1) * 16384 + (size_t)(tid + NTHR * i) * 8);
        }
        lds_barrier();
#pragma unroll
        for (int rt = 0; rt < 4; ++rt) {
            f32x4 acc = {0.f, 0.f, 0.f, 0.f};
#pragma unroll
            for (int ks = 0; ks < 8; ++ks) acc = MFMA16(*(const LAS bf16x8*)(img + (16 * rt + fr) * S5_PITCH + 64 * ks + 16 * fq), wstf[ks], acc);
#pragma unroll
            for (int jj = 0; jj < 4; ++jj) Sl[(16 * rt + 4 * fq + jj) * 128 + 16 * wave + fr] = acc[jj];
        }
        lds_barrier();
        if (wave == 0) {
#pragma unroll 1
            for (int cb = 0; cb < 64; cb += 16) {
                float xs[16], ys[16]; unsigned short er[16], ei[16];
#pragma unroll
                for (int c = 0; c < 16; ++c) { xs[c] = Sl[(cb + c) * 128 + lane]; ys[c] = Sl[(cb + c) * 128 + 64 + lane]; }
#pragma unroll
                for (int c = 0; c < 16; ++c) { er[c] = f2bf(sr); ei[c] = f2bf(si); const float nr = a16.x * sr - a16.y * si + xs[c], ni = a16.x * si + a16.y * sr + ys[c]; sr = nr; si = ni; }
#pragma unroll
                for (int c = 0; c < 16; ++c) { *(LAS bf16*)(img + (cb + c) * S5_PITCH + 512 + 2 * lane) = er[c]; *(LAS bf16*)(img + (cb + c) * S5_PITCH + 640 + 2 * lane) = ei[c]; }
            }
        }
        f32x4 yacc[4][2];
#pragma unroll
        for (int rt = 0; rt < 4; ++rt) {
            yacc[rt][0] = (f32x4){0.f, 0.f, 0.f, 0.f}; yacc[rt][1] = (f32x4){0.f, 0.f, 0.f, 0.f};
#pragma unroll
            for (int ks = 0; ks < 8; ++ks) { const bf16x8 af = *(const LAS bf16x8*)(img + (16 * rt + fr) * S5_PITCH + 64 * ks + 16 * fq);
                yacc[rt][0] = MFMA16(w2f[0][ks], af, yacc[rt][0]); yacc[rt][1] = MFMA16(w2f[1][ks], af, yacc[rt][1]); }
        }
        lds_barrier();
#pragma unroll
        for (int rt = 0; rt < 4; ++rt) {
#pragma unroll
            for (int ks = 8; ks < 12; ++ks) { const bf16x8 af = *(const LAS bf16x8*)(img + (16 * rt + fr) * S5_PITCH + 64 * ks + 16 * fq);
                yacc[rt][0] = MFMA16(w2f[0][ks], af, yacc[rt][0]); yacc[rt][1] = MFMA16(w2f[1][ks], af, yacc[rt][1]); }
#pragma unroll
            for (int c2 = 0; c2 < 2; ++c2) { const f32x4 v = yacc[rt][c2]; u32x2 o; o.x = pk2(gelu_t(v[0]), gelu_t(v[1])); o.y = pk2(gelu_t(v[2]), gelu_t(v[3]));
                *(u32x2*)(G + (size_t)(b * SEQ + 16 * (64 * q + 16 * rt + fr) + 2 * wave + c2) * MW + g * 16 + 4 * fq) = o; }
        }
    }
}

constexpr int ATT_VP = 160;
__device__ __forceinline__ void stage_attn(const bf16* Qb, const bf16* Kb, const bf16* Vb, bf16* YS, LAS unsigned char* lds, int unit, int wave, int lane) {
    const int b = unit >> 7, hd = (unit >> 4) & 7, qb = unit & 15, t0 = 256 * qb + 32 * wave, r = lane & 31, hh = lane >> 5;
    const size_t hoff = (size_t)(b * 8 + hd) * SEQ * 128; const bf16* Qh = Qb + hoff; const bf16* Kh = Kb + hoff; const bf16* Vh = Vb + hoff;
    LAS bf16* Vs = (LAS bf16*)(lds + wave * (32 * ATT_VP * 2));
    bf16x8 qf[8], kf[8]; u32x4 vr[8];
#pragma unroll
    for (int ks = 0; ks < 8; ++ks) qf[ks] = *(const bf16x8*)(Qh + (size_t)(t0 + r) * 128 + 16 * ks + 8 * hh);
#define ATT_LOAD(S0) do { _Pragma("unroll") for (int ks = 0; ks < 8; ++ks) kf[ks] = *(const bf16x8*)(Kh + (size_t)((S0) + r) * 128 + 16 * ks + 8 * hh); \
        _Pragma("unroll") for (int i = 0; i < 8; ++i) vr[i] = *(const u32x4*)(Vh + (size_t)((S0) + (lane >> 4) + 4 * i) * 128 + 8 * (lane & 15)); } while (0)
    ATT_LOAD(t0);
    f32x16 o[4];
#pragma unroll
    for (int dt = 0; dt < 4; ++dt)
#pragma unroll
        for (int i = 0; i < 16; ++i) o[dt][i] = 0.f;
    float C = 1.f;
    const float c1 = 0.08838834764831845f * 1.4426950408889634f;
    const int trl = ((lane & 15) >> 2) * ATT_VP + 16 * ((lane >> 4) & 1) + 4 * (lane & 3);
    for (int s0 = t0;;) {
#pragma unroll
        for (int i = 0; i < 8; ++i) *(LAS u32x4*)(Vs + ((lane >> 4) + 4 * i) * ATT_VP + 8 * (lane & 15)) = vr[i];
        asm volatile("" ::: "memory");
        f32x16 z;
#pragma unroll
        for (int i = 0; i < 16; ++i) z[i] = 0.f;
#pragma unroll
        for (int ks = 0; ks < 8; ++ks) z = MFMA32(kf[ks], qf[ks], z);
        const int sn = s0 - 32;
        if (sn >= 0) ATT_LOAD(sn);
        float be[16], om[16], w[16];
#pragma unroll
        for (int i = 0; i < 16; ++i) { const float zr = z[i]; const float e = __builtin_amdgcn_exp2f(-fabsf(zr) * c1); const float rc = __builtin_amdgcn_rcpf(1.f + e), er = e * rc; const bool pos = zr > 0.f; be[i] = pos ? rc : er; om[i] = pos ? er : rc; }
        if (s0 == t0) {
#pragma unroll
            for (int i = 0; i < 16; ++i) { const bool valid = crow(i, hh) < r; be[i] = valid ? be[i] : 0.f; om[i] = valid ? om[i] : 1.f; }
        }
        float gp[4], pgp[4], aft[4];
#pragma unroll
        for (int gi = 0; gi < 4; ++gi) { w[4 * gi + 3] = 1.f; w[4 * gi + 2] = om[4 * gi + 3]; w[4 * gi + 1] = om[4 * gi + 2] * w[4 * gi + 2]; w[4 * gi] = om[4 * gi + 1] * w[4 * gi + 1]; gp[gi] = om[4 * gi] * w[4 * gi]; pgp[gi] = __shfl_xor(gp[gi], 32); }
        float run = 1.f;
#pragma unroll
        for (int gi = 3; gi >= 0; --gi) { aft[gi] = (hh ? run : run * pgp[gi]) * C; run *= gp[gi] * pgp[gi]; }
#pragma unroll
        for (int i = 0; i < 16; ++i) w[i] = be[i] * w[i] * aft[i >> 2];
        C *= run;
#pragma unroll
        for (int s = 0; s < 2; ++s) {
            u32x4 wp;
#pragma unroll
            for (int j = 0; j < 4; ++j) wp[j] = pk2(w[8 * s + 2 * j], w[8 * s + 2 * j + 1]);
            const bf16x8 wf = __builtin_bit_cast(bf16x8, wp);
#pragma unroll
            for (int dt = 0; dt < 4; ++dt) {
                const LAS bf16* vb = Vs + (16 * s + 4 * hh) * ATT_VP + 32 * dt + trl;
                const s16x4 lo = __builtin_amdgcn_ds_read_tr16_b64_v4i16((LAS s16x4*)vb), hi = __builtin_amdgcn_ds_read_tr16_b64_v4i16((LAS s16x4*)(vb + 8 * ATT_VP));
                o[dt] = MFMA32(__builtin_shufflevector(lo, hi, 0, 1, 2, 3, 4, 5, 6, 7), wf, o[dt]);
            }
        }
        if (sn < 0 || __all(C == 0.f)) break;
        s0 = sn;
    }
#undef ATT_LOAD
    bf16* orow = YS + (size_t)(b * SEQ + t0 + r) * YSW + 2 * MW + hd * 128;
#pragma unroll
    for (int dt = 0; dt < 4; ++dt)
#pragma unroll
        for (int gi = 0; gi < 4; ++gi) { u32x2 v; v.x = pk2(o[dt][4 * gi], o[dt][4 * gi + 1]); v.y = pk2(o[dt][4 * gi + 2], o[dt][4 * gi + 3]); *(u32x2*)(orow + 32 * dt + 8 * gi + 4 * hh) = v; }
}
#ifndef MK_DUP
#define MK_DUP -1
#endif
#define REP(k) for (int rep_ = 0; rep_ < ((MK_DUP) == (k) ? 2 : 1); ++rep_)
#ifndef STAG_NG
#define STAG_NG 1
#endif
#ifndef STAG_US
#define STAG_US 0
#endif
#define STAGGER() do { if (STAG_NG > 1) { const unsigned long long t0_ = __builtin_amdgcn_s_memrealtime(), dl_ = (unsigned long long)((bid >> 3) % STAG_NG) * (STAG_US) * 100ull; while (__builtin_amdgcn_s_memrealtime() - t0_ < dl_) __builtin_amdgcn_s_sleep(32); } } while (0)
#ifndef MK_SUB
#define MK_SUB 7
#endif
#ifndef MK_ONLY_PRO
#define MK_ONLY_PRO 1
#endif
#ifndef MK_ONLY_FIN
#define MK_ONLY_FIN 1
#endif
struct Args { const float* in[23]; float* out; unsigned char* ws; int l_lo, l_hi, ph_lo, ph_hi, pro, fin; };
constexpr int NPH = 10;
__global__ void __launch_bounds__(NTHR, 2) mk_fwd(Args a) {
    extern __shared__ __attribute__((aligned(16))) unsigned char lds_raw[];
    LAS unsigned char* lds = (LAS unsigned char*)lds_raw;
    const int wave_s = __builtin_amdgcn_readfirstlane(threadIdx.x >> 6);
    const int G = gridDim.x, ngw = G * NWAVES;
    unsigned char* ws = a.ws;
    for (int u = threadIdx.x; u < (LDS_BYTES - LDS_CTL_OFF) / 4; u += NTHR) ((LAS unsigned*)(lds + LDS_CTL_OFF))[u] = 0u;
    __syncthreads();
    XcdBarrier bar = xcd_barrier_post((unsigned*)(ws + WS_CTL), (volatile LAS unsigned*)(lds + LDS_CTL_OFF));
    float* X = (float*)(ws + WS_X); bf16* H = (bf16*)(ws + WS_H); bf16* P = (bf16*)(ws + WS_PROJ); unsigned char* pj = ws + WS_PROJ; bf16* Gb = (bf16*)(ws + WS_G); bf16* YS = (bf16*)(ws + WS_YS);
    bf16* MG = (bf16*)(ws + WS_MERGED); bf16* HID = (bf16*)(ws + WS_HID); float* VSQ = (float*)(ws + WS_VSQ); float* RSQa = (float*)(ws + WS_RSQ); float* RSQb = RSQa + (size_t)M * 32; bf16* SST = (bf16*)(ws + WS_SST);

#define LAUNDER() int lane_l, wave_l = wave_s, bid_l = blockIdx.x; asm volatile("v_mbcnt_lo_u32_b32 %0, -1, 0\n\tv_mbcnt_hi_u32_b32 %0, -1, %0" : "=v"(lane_l)); asm volatile("" : "+s"(wave_l), "+s"(bid_l)); const int lane = lane_l, wave = wave_l, bid = bid_l, tid = wave_l * 64 + lane_l, gw = bid_l * NWAVES + wave_l; (void)tid; (void)lane; (void)wave; (void)gw; (void)bid
    if ((MK_ONLY_PRO) && a.pro) REP(100) {
        LAUNDER();
        const ConvSrc cs{a.in[2], a.in[15], a.in[17], a.in[18], a.in[20], a.in[21], a.in[1], a.in[19]};
        if (G == 256) phase_conv(cs, ws, lds, gw, ngw, wave, lane, 0, CV_T_IN, CV_TL);
        else phase_conv(cs, ws, lds, gw, ngw, wave, lane, 0, CV_TL, 0);
        const S5Src ss{a.in[7], a.in[8], a.in[9], a.in[10], a.in[11], a.in[12], a.in[13], a.in[14]};
        phase_s5prep(ss, ws, lds, tid);
        phase_norm0(a.in[0], H, RSQb, gw, ngw, lane);
        xcd_barrier(bar, tid == 0);
    }
    for (int l = a.l_lo; l < a.l_hi; ++l) {
        unsigned char* wl = ws + WS_W + (size_t)l * WL_SIZE;
        const float* xsrc = (l == 0) ? a.in[0] : X;
#ifndef MK_ONLY
#define MK_ONLY -1
#endif
#ifndef MK_MASK
#define MK_MASK 0x3ff
#endif
#define IN(k) ((MK_ONLY < 0 || MK_ONLY == (k)) && ((MK_MASK >> (k)) & 1) && a.ph_lo <= (k) && (k) < a.ph_hi)
        if (IN(1)) REP(1) {
            LAUNDER();
            pg8::Gemm g{H, (const bf16*)(wl + WL_IN), M, PC, D}; pg8::StaticOrder S; S.init(M, PC, G, bid);
            LAS float* tab = (LAS float*)(lds + 131072); pg8::Unit u0; int pm0 = -1; if (S.next(0, u0)) { pm0 = u0.pm; rstd_table(RSQb, pm0, tab, tid); } __syncthreads();
            pg8::EpiProj E{P, a.in[3] + (size_t)l * 3 * D, VSQ, RSQb, tab, pm0};
            const int cpos = (l == 0 && G == 256) ? ((bid & 7) < 6 ? (bid & 7) : 6) : -1;
#pragma unroll 1
            for (int part = 0; part < 2; ++part) {
                LAUNDER();
                if (part) {
                    if (cpos < 0) break;
                    const ConvSrc cs{a.in[2], a.in[15], a.in[17], a.in[18], a.in[20], a.in[21], a.in[1], a.in[19]};
                    phase_conv(cs, ws, lds, gw, ngw, wave, lane, CV_T_IN, CV_TL, CV_LATE);
                    __syncthreads(); if (pm0 >= 0) rstd_table(RSQb, pm0, tab, tid); __syncthreads();
                }
                pg8::SubOrder SS{S, part ? cpos : 0, (part || cpos < 0) ? (1 << 20) : cpos};
                pg8::gemm_phase<pg8::EpiProj, pg8::SubOrder, true, true>(lds, g, SS, E, tid);
            }
            xcd_barrier(bar, tid == 0);
        }
        if (IN(2)) REP(2) {
            LAUNDER();
            const bool attn_first = (G == 256) && bid >= 128;
#define MIX_ATTN() do { if (MK_SUB & 4) REP(22) for (int u = bid; u < 256; u += G) stage_attn((const bf16*)(pj + PJ_Q), (const bf16*)(pj + PJ_K), (const bf16*)(pj + PJ_V), YS, lds, u, wave, lane); } while (0)
            if (attn_first) { lds_barrier(); MIX_ATTN(); lds_barrier(); }
            if (MK_SUB & 1) REP(20) for (int u = bid; u < 128; u += G) stage_s5((const bf16*)(pj + PJ_SIN), (const bf16*)(wl + WL_WST), (const bf16*)(wl + WL_W2), (const float2*)(wl + WL_A16), Gb, lds, u, tid, wave, lane);
            if (MK_SUB & 2) REP(21) for (int u = (G == 256 ? (bid >= 128 ? bid - 128 : 512) : bid); u < 512; u += (G == 256 ? 128 : G)) stage_gmlp((const bf16*)(pj + PJ_U), (const bf16*)(pj + PJ_VG), VSQ, a.in[4] + (size_t)l * MW, a.in[5] + (size_t)l * 8 * 128 * 128, a.in[6] + (size_t)l * 8 * 128, YS, lds, u, tid, wave, lane);
            if (!attn_first) { lds_barrier(); MIX_ATTN(); }
#undef MIX_ATTN
            xcd_barrier(bar, tid == 0);
        }
        if (IN(4)) REP(4) {
            LAUNDER();
            pg8::Gemm g{Gb, (const bf16*)(wl + WL_GLU), M, MW, MW}; pg8::StaticOrder S; S.init(M, MW, G, bid);
            pg8::EpiGlu E{Gb, a.in[16] + (size_t)l * MW, YS};
            pg8::gemm_phase<pg8::EpiGlu, pg8::StaticOrder, true, true>(lds, g, S, E, tid);
            if (G == 256 && bid >= 128 && l + 1 < DEPTH) {
                const ConvSrc cs{a.in[2], a.in[15], a.in[17], a.in[18], a.in[20], a.in[21], a.in[1], a.in[19]};
                phase_conv_late(cs, ws, lds, l + 1, (bid - 128) * NWAVES + wave, 128 * NWAVES, wave, lane, CV_LATE);
            }
            xcd_barrier(bar, tid == 0);
        }
        if (IN(5)) REP(5) {
            LAUNDER();
            pg8::Gemm g{YS, (const bf16*)(wl + WL_BR), M, D, 3 * MW}; pg8::StaticOrder S; S.init(M, D, G, bid);
            pg8::EpiBranch E{(const bf16*)(pj + PJ_GT), MG};
            pg8::gemm_phase<pg8::EpiBranch, pg8::StaticOrder, true, true>(lds, g, S, E, tid);
            xcd_barrier(bar, tid == 0);
        }
        if (IN(6)) REP(6) {
            LAUNDER();
            pg8::Gemm g{MG, (const bf16*)(wl + WL_OUT), M, D, D}; pg8::StaticOrder S; S.init(M, D, G, bid);
            bf16* Hs = (bf16*)(ws + WS_SALL + 64 * MiB); float* Rs = (float*)(ws + WS_SALL + 96 * MiB);
            pg8::EpiResN E{l == 0 ? a.in[0] : nullptr, H, rep_ ? Hs : H, nullptr, rep_ ? Rs : RSQa};
            pg8::gemm_phase<pg8::EpiResN, pg8::StaticOrder, true, true>(lds, g, S, E, tid);
            xcd_barrier(bar, tid == 0);
        }
        if (IN(8)) REP(8) {
            LAUNDER();
            pg8::Gemm g{H, (const bf16*)(wl + WL_MI), M, DFF, D}; pg8::StaticOrder S; S.init(M, DFF, G, bid);
            LAS float* tab = (LAS float*)(lds + 131072); pg8::Unit u0; int pm0 = -1; if (S.next(0, u0)) { pm0 = u0.pm; rstd_table(RSQa, pm0, tab, tid); } __syncthreads();
            pg8::EpiRelu2 E{HID, RSQa, tab, pm0};
            STAGGER();
            pg8::gemm_phase<pg8::EpiRelu2, pg8::StaticOrder, true, true>(lds, g, S, E, tid);
            xcd_barrier(bar, tid == 0);
        }
        if (IN(9)) REP(9) {
            LAUNDER();
            pg8::Gemm g{HID, (const bf16*)(wl + WL_MO), M, D, DFF}; pg8::StaticOrder S; S.init(M, D, G, bid);
            bf16* Hs = (bf16*)(ws + WS_SALL + 64 * MiB); float* Rs = (float*)(ws + WS_SALL + 96 * MiB);
            pg8::EpiResN E{nullptr, H, rep_ ? Hs : H, (l == DEPTH - 1) ? X : nullptr, rep_ ? Rs : RSQb};
            pg8::gemm_phase<pg8::EpiResN, pg8::StaticOrder, true, true>(lds, g, S, E, tid);
            xcd_barrier(bar, tid == 0);
        }
#undef IN
    }
    if ((MK_ONLY_FIN) && a.fin) { LAUNDER(); phase_rmsnorm_f32(X, a.in[22], a.out, gw, ngw, lane); }
}
#ifndef MK_MODE
#define MK_MODE 0
#endif
static void mk_launch(const Args& a0, int grid, hipStream_t stream, int pro, int fin, int l_lo, int l_hi, int ph_lo, int ph_hi) {
    Args a = a0; a.pro = pro; a.fin = fin; a.l_lo = l_lo; a.l_hi = l_hi; a.ph_lo = ph_lo; a.ph_hi = ph_hi;
    hipMemsetAsync(a.ws + WS_CTL, 0, 16384, stream);
    hipLaunchKernelGGL(mk_fwd, dim3(grid), dim3(NTHR), LDS_BYTES, stream, a);
}
extern "C" void kernel_launch(void* const* d_in, const int* in_sizes, int n_in, void* d_out, int out_size, void* d_ws, size_t ws_size, hipStream_t stream) {
    static int grid = 0;
    if (grid == 0) {
        if (n_in != 23 || out_size != M * D || ws_size < WS_END) { fprintf(stderr, "kernel_launch: unexpected shapes (n_in %d out %d ws %zu need %zu)\n", n_in, out_size, ws_size, (size_t)WS_END); grid = -1; return; }
        int dev = 0, cus = 0, per_cu = 0;
        if (hipGetDevice(&dev) != hipSuccess || hipDeviceGetAttribute(&cus, hipDeviceAttributeMultiprocessorCount, dev) != hipSuccess) { grid = -1; return; }
        if (hipFuncSetAttribute((const void*)mk_fwd, hipFuncAttributeMaxDynamicSharedMemorySize, LDS_BYTES) != hipSuccess) { fprintf(stderr, "kernel_launch: hipFuncSetAttribute failed\n"); grid = -1; return; }
        if (hipOccupancyMaxActiveBlocksPerMultiprocessor(&per_cu, (const void*)mk_fwd, NTHR, LDS_BYTES) != hipSuccess || per_cu < 1) { fprintf(stderr, "kernel_launch: occupancy query says %d\n", per_cu); }
        (void)hipGetLastError();
        grid = cus;
    }
    if (grid < 0) return;
    Args a{};
    for (int i = 0; i < 23; ++i) a.in[i] = (const float*)d_in[i];
    a.out = (float*)d_out; a.ws = (unsigned char*)d_ws;
#if MK_MODE == 0
    mk_launch(a, grid, stream, 1, 1, 0, DEPTH, 0, NPH);
#else
    unsigned char* ws = (unsigned char*)d_ws;
    bf16* P = (bf16*)(ws + WS_PROJ); bf16* G = (bf16*)(ws + WS_G); bf16* YS = (bf16*)(ws + WS_YS); float* VRS = (float*)(ws + WS_VRS); float2* SALL = (float2*)(ws + WS_SALL);
    const float* gm_norm_g = a.in[4]; const float* gm_w_s = a.in[5]; const float* gm_b_s = a.in[6];
    const float* lre = a.in[7]; const float* lim = a.in[8]; const float* ldt = a.in[9]; const float* bre = a.in[10]; const float* bim = a.in[11]; const float* cre = a.in[12]; const float* cim = a.in[13]; const float* s5d = a.in[14];
    mk_launch(a, grid, stream, 1, 0, 0, 0, 0, 0);
    for (int l = 0; l < DEPTH; ++l) {
        mk_launch(a, grid, stream, 0, 0, l, l + 1, 0, 2);
        if (MK_SUB) mk_launch(a, grid, stream, 0, 0, l, l + 1, 2, 4);
        if (!(MK_SUB & 2)) {
            hipLaunchKernelGGL(k_vrstd, dim3(2048), dim3(256), 0, stream, (const bf16*)P, VRS);
            hipLaunchKernelGGL(k_ogmlp, dim3(64 * 8), dim3(256), 0, stream, (const bf16*)P, (const float*)VRS, gm_norm_g + (size_t)l * MW, gm_w_s + (size_t)l * 8 * 128 * 128, gm_b_s + (size_t)l * 8 * 128, YS);
        }
        if (!(MK_SUB & 1)) {
            hipLaunchKernelGGL(k_os5_scan, dim3(BATCH * 64), dim3(64), 0, stream, (const bf16*)P, lre + (size_t)l * 4096, lim + (size_t)l * 4096, ldt + (size_t)l * 64, bre + (size_t)l * 65536, bim + (size_t)l * 65536, SALL);
            hipLaunchKernelGGL(k_os5_out, dim3(M * MW / 256), dim3(256), 0, stream, (const bf16*)P, (const float2*)SALL, cre + (size_t)l * 65536, cim + (size_t)l * 65536, s5d + (size_t)l * MW, G);
        }
        if (!(MK_SUB & 4)) hipLaunchKernelGGL(k_oattn, dim3(BATCH * 8 * SEQ), dim3(64), 0, stream, (const bf16*)P, YS);
        mk_launch(a, grid, stream, 0, 0, l, l + 1, 4, NPH);
    }
    mk_launch(a, grid, stream, 0, 1, 0, 0, 0, 0);
#endif
}
```

```cpp
#include <hip/hip_runtime.h>
#include <stdint.h>
#include <stdio.h>

typedef unsigned short bf16;
typedef short bf16x8 __attribute__((ext_vector_type(8)));
typedef float f32x4 __attribute__((ext_vector_type(4)));
typedef float f32x16 __attribute__((ext_vector_type(16)));
typedef unsigned u32x4 __attribute__((ext_vector_type(4)));
typedef unsigned u32x2 __attribute__((ext_vector_type(2)));
typedef float f32x2 __attribute__((ext_vector_type(2)));

constexpr int D = 2048, BATCH = 2, SEQ = 4096, DEPTH = 4, M = BATCH * SEQ;
constexpr int MW = 1024, PC = 12288, DFF = 8192;
constexpr int OFF_U = 0, OFF_V = 1024, OFF_S5 = 2048, OFF_Q = 3072, OFF_K = 4096, OFF_VV = 5120, OFF_G = 6144;
constexpr int YSW = 3072;
constexpr float EPS = 1e-6f;

constexpr size_t MiB = 1u << 20;
constexpr size_t WS_CTL = 0;
constexpr size_t WL_IN = 0, WL_GLU = 48 * MiB, WL_BR = 50 * MiB, WL_OUT = 62 * MiB, WL_MI = 70 * MiB, WL_MO = 102 * MiB;
constexpr size_t WL_WST = 134 * MiB;
constexpr size_t WL_W2 = 138 * MiB;
constexpr size_t WL_A16 = 150 * MiB;
constexpr size_t WL_SIZE = 151 * MiB;
constexpr size_t WS_W = 1 * MiB;
constexpr size_t WS_X = WS_W + DEPTH * WL_SIZE;
constexpr size_t WS_H = WS_X + 64 * MiB;
constexpr size_t WS_PROJ = WS_H + 32 * MiB;
constexpr size_t PJ_U = 0, PJ_VG = 16 * MiB;
constexpr size_t PJ_SIN = 32 * MiB;
constexpr size_t PJ_Q = 48 * MiB, PJ_K = 64 * MiB, PJ_V = 80 * MiB;
constexpr size_t PJ_GT = 96 * MiB;
constexpr size_t WS_G = WS_PROJ + 192 * MiB;
constexpr size_t WS_YS = WS_G + 16 * MiB;
constexpr size_t WS_MERGED = WS_YS + 48 * MiB;
constexpr size_t WS_HID = WS_MERGED + 32 * MiB;
constexpr size_t WS_VSQ = WS_HID + 128 * MiB;
constexpr size_t WS_SST = WS_VSQ + 1 * MiB;
constexpr size_t WS_RSQ = WS_SST + 8 * MiB;
constexpr size_t WS_VRS = WS_RSQ + 2 * MiB;
constexpr size_t WS_SALL = WS_VRS + 1 * MiB;
constexpr size_t WS_END = WS_SALL + 256 * MiB;

__device__ __forceinline__ float bf2f(bf16 v) { return __uint_as_float(((unsigned)v) << 16); }
typedef __bf16 bf16x2_t __attribute__((ext_vector_type(2)));
__device__ __forceinline__ unsigned pk2(float lo, float hi) { const f32x2 v = {lo, hi}; return __builtin_bit_cast(unsigned, __builtin_convertvector(v, bf16x2_t)); }
__device__ __forceinline__ bf16 f2bf(float f) { return (bf16)(pk2(f, 0.f) & 0xffffu); }
__device__ __forceinline__ float gelu_t(float x) { const float u = 0.7978845608028654f * (x + 0.044715f * x * x * x); return x * __builtin_amdgcn_rcpf(1.f + __expf(-2.f * u)); }
__device__ __forceinline__ float sigmoid_f(float x) { return __builtin_amdgcn_rcpf(1.f + __expf(-x)); }
__device__ __forceinline__ float softplus_f(float z) { return fmaxf(z, 0.f) + __logf(1.f + __expf(-fabsf(z))); }
__device__ __forceinline__ float wave_sum(float v) {
#pragma unroll
    for (int o = 1; o < 64; o <<= 1) v += __shfl_xor(v, o);
    return v;
}
__device__ __forceinline__ float bflo(unsigned w) { return __uint_as_float(w << 16); }
__device__ __forceinline__ float bfhi(unsigned w) { return __uint_as_float(w & 0xffff0000u); }
#define MK_MODE 0
#define MK_SUB 7
#define MK_DUP -1
#define STAG_NG 1
#define STAG_US 0
#define MK_DIAG -1
#define MK_DIAGV 0
#define MK_DIAGL 0
namespace pg8 {
#define PG8_LAS __attribute__((address_space(3)))
typedef unsigned short bf16_t;
typedef short bf16x8 __attribute__((ext_vector_type(8)));
typedef float f32x4 __attribute__((ext_vector_type(4)));
typedef unsigned u32x4 __attribute__((ext_vector_type(4)));
constexpr int BM = 256, BK = 64, HALF = 128, HTB = HALF * BK * 2  , STAGE_BYTES = 8 * HTB, NXCD = 8, WGM = 8;

__host__ __device__ __forceinline__ int lds_byte(int r, int c) { const int st = (r >> 4) * 2 + (c >> 5), rr = r & 15, cc = c & 31, ob = rr * 64 + cc * 2; return st * 1024 + (ob ^ (((ob >> 9) & 1) << 5)); }
__host__ __device__ __forceinline__ void stage_rc(int b, int& R, int& C) { const int st = b / 1024, sb = b % 1024, swz = sb ^ (((sb >> 9) & 1) << 5); R = (st >> 1) * 16 + swz / 64; C = (st & 1) * 32 + (swz % 64) / 2; }
__host__ __device__ __forceinline__ int perm32(int rho) { const int n = rho >> 4, i = rho & 15; return 8 * (i >> 2) + 4 * n + (i & 3); }

struct Unit { int pm, pn; };
struct Gemm { const bf16_t* A; const bf16_t* Bt; int M, N, K; };

struct StaticOrder {
    int nM, nN, nwg, G, c;
    __host__ __device__ void init(int M, int N, int G_, int c_) { nM = M / BM; nN = N / BM; nwg = nM * nN; G = G_; c = c_; }
    __host__ __device__ bool next(int i, Unit& u) const {
        const long L = (long)i * G + c; if (L >= nwg) return false;
        int wgid = (int)L; { const int q = nwg / NXCD, r = nwg % NXCD, xcd = wgid % NXCD, off = wgid / NXCD; wgid = (xcd < r ? xcd * (q + 1) : r * (q + 1) + (xcd - r) * q) + off; }
        const int nig = WGM * nN, gid = wgid / nig, fm = gid * WGM, gsz = (nM - fm) < WGM ? (nM - fm) : WGM;
        u.pm = fm + ((wgid % nig) % gsz); u.pn = (wgid % nig) / gsz; return true;
    }
    __device__ __forceinline__ void a_ready(const Unit&) const {}
    __device__ __forceinline__ void done(const Unit&) const {}
};
struct SubOrder {
    StaticOrder S; int lo, hi;
    __host__ __device__ bool next(int i, Unit& u) const { return (lo + i < hi) && S.next(lo + i, u); }
    __device__ __forceinline__ void a_ready(const Unit&) const {}
    __device__ __forceinline__ void done(const Unit&) const {}
};
__device__ __forceinline__ unsigned cvt_pk_bf16(float lo, float hi) { unsigned r; asm volatile("v_cvt_pk_bf16_f32 %0, %1, %2" : "=v"(r) : "v"(lo), "v"(hi)); return r; }
__device__ __forceinline__ u32x4 pack8(const f32x4& v0, const f32x4& v1) { u32x4 w; w.x = cvt_pk_bf16(v0[0], v0[1]); w.y = cvt_pk_bf16(v0[2], v0[3]); w.z = cvt_pk_bf16(v1[0], v1[1]); w.w = cvt_pk_bf16(v1[2], v1[3]); return w; }
__device__ __forceinline__ void unpack8(const u32x4& w, f32x4& v0, f32x4& v1) { v0 = (f32x4){bflo(w.x), bfhi(w.x), bflo(w.y), bfhi(w.y)}; v1 = (f32x4){bflo(w.z), bfhi(w.z), bflo(w.w), bfhi(w.w)}; }

__device__ __forceinline__ float row_rstd(const float* rsq, const PG8_LAS float* tab, int pm0, int pm, int r) {
    if (pm == pm0) return tab[r];
    const f32x4* q = (const f32x4*)(rsq + (size_t)(pm * BM + r) * 32); float s = 0.f;
#pragma unroll
    for (int i = 0; i < 8; ++i) { const f32x4 v = q[i]; s += (v[0] + v[1]) + (v[2] + v[3]); }
    return rsqrtf(s * (1.f / D) + EPS);
}
struct EpiProj {
    static constexpr bool PERM = true, AFTER_DRAIN = false, RESCALE = false, TWICE = (MK_DUP == 31);
    bf16_t* PJ; const float* bg; float* vsq; const float* rsq; const PG8_LAS float* tab; int pm0;
    __device__ __forceinline__ void rescale(f32x4 (&)[2][2][4][2], const Unit&, int, int, int, int, int) const {}
    template <int KIND> __device__ __forceinline__ void run(const f32x4 (&acc)[2][2][4][2], const Unit& u, int wr, int wc, int fr, int fq) const {
        const int row0 = u.pm * BM + wr * 64 + fr, col0 = u.pn * BM + wc * 32 + 8 * fq;
        f32x4 bv[2][2];
        if (KIND == 4) {
#pragma unroll
            for (int bj = 0; bj < 2; ++bj)
#pragma unroll
                for (int n = 0; n < 2; ++n) bv[bj][n] = *(const f32x4*)(bg + (col0 - OFF_G) + bj * HALF + 4 * n);
        }
        unsigned char* pjb = (unsigned char*)PJ;
        float rs[2][4];
#pragma unroll
        for (int ai = 0; ai < 2; ++ai)
#pragma unroll
            for (int m = 0; m < 4; ++m) rs[ai][m] = row_rstd(rsq, tab, pm0, u.pm, wr * 64 + fr + ai * HALF + m * 16);
#pragma unroll
        for (int ai = 0; ai < 2; ++ai)
#pragma unroll
            for (int m = 0; m < 4; ++m) {
                const int row = row0 + ai * HALF + m * 16; float ss = 0.f;
#pragma unroll
                for (int bj = 0; bj < 2; ++bj) {
                    const int col = col0 + bj * HALF; bf16_t* dst;
                    if (KIND == 0) dst = (bf16_t*)(pjb + PJ_U) + (size_t)row * MW + col;
                    else if (KIND == 1) dst = (bf16_t*)(pjb + PJ_VG) + (size_t)row * MW + (col - OFF_V);
                    else if (KIND == 2) { const int c = col - OFF_S5; dst = (bf16_t*)(pjb + PJ_SIN) + ((size_t)((row >> 12) * 64 + (c >> 4)) * SEQ + (row & (SEQ - 1))) * 16 + (c & 15); }
                    else if (KIND == 3) { const int c = col - OFF_Q; dst = (bf16_t*)(pjb + PJ_Q + (size_t)(c >> 10) * (PJ_K - PJ_Q)) + ((size_t)((row >> 12) * 8 + ((c >> 7) & 7)) * SEQ + (row & (SEQ - 1))) * 128 + (c & 127); }
                    else dst = (bf16_t*)(pjb + PJ_GT) + (size_t)row * (3 * D) + (col - OFF_G);
                    f32x4 v0 = acc[ai][bj][m][0] * rs[ai][m], v1 = acc[ai][bj][m][1] * rs[ai][m];
                    if (KIND <= 1) {
#pragma unroll
                        for (int j = 0; j < 4; ++j) { v0[j] = gelu_t(v0[j]); v1[j] = gelu_t(v1[j]); }
                        if (KIND == 1) ss += (v0[0] * v0[0] + v0[1] * v0[1]) + (v0[2] * v0[2] + v0[3] * v0[3]) + (v1[0] * v1[0] + v1[1] * v1[1]) + (v1[2] * v1[2] + v1[3] * v1[3]);
                    } else if (KIND == 4) {
                        v0 = v0 + bv[bj][0]; v1 = v1 + bv[bj][1];
#pragma unroll
                        for (int j = 0; j < 4; ++j) { v0[j] = fmaxf(sigmoid_f(v0[j]), 1e-30f); v1[j] = fmaxf(sigmoid_f(v1[j]), 1e-30f); }
                    }
                    *(u32x4*)dst = pack8(v0, v1);
                }
                if (KIND == 1) { ss += __shfl_xor(ss, 16); ss += __shfl_xor(ss, 32); if (fq == 0) vsq[(size_t)row * 16 + (u.pn - 4) * 4 + wc] = ss; }
            }
    }
    __device__ __forceinline__ void operator()(const f32x4 (&acc)[2][2][4][2], const Unit& u, int wr, int wc, int fr, int fq) const {
        if (u.pn < 4) run<0>(acc, u, wr, wc, fr, fq);
        else if (u.pn < 8) run<1>(acc, u, wr, wc, fr, fq);
        else if (u.pn < 12) run<2>(acc, u, wr, wc, fr, fq);
        else if (u.pn < 24) run<3>(acc, u, wr, wc, fr, fq);
        else run<4>(acc, u, wr, wc, fr, fq);
    }
};
struct EpiGlu {
    static constexpr bool PERM = true, AFTER_DRAIN = false, RESCALE = false, TWICE = false;
    const bf16_t* G; const float* b; bf16_t* YS;
    __device__ __forceinline__ void rescale(f32x4 (&)[2][2][4][2], const Unit&, int, int, int, int, int) const {}
    __device__ __forceinline__ void operator()(const f32x4 (&acc)[2][2][4][2], const Unit& u, int wr, int wc, int fr, int fq) const {
        const int row0 = u.pm * BM + wr * 64 + fr, col0 = u.pn * BM + wc * 32 + 8 * fq;
        f32x4 bv[2][2];
#pragma unroll
        for (int bj = 0; bj < 2; ++bj)
#pragma unroll
            for (int n = 0; n < 2; ++n) bv[bj][n] = *(const f32x4*)(b + col0 + bj * HALF + 4 * n);
#pragma unroll
        for (int ai = 0; ai < 2; ++ai)
#pragma unroll
            for (int m = 0; m < 4; ++m) {
                const int row = row0 + ai * HALF + m * 16;
#pragma unroll
                for (int bj = 0; bj < 2; ++bj) {
                    f32x4 g0, g1; unpack8(*(const u32x4*)(G + (size_t)row * MW + col0 + bj * HALF), g0, g1);
                    f32x4 v0 = acc[ai][bj][m][0] + bv[bj][0], v1 = acc[ai][bj][m][1] + bv[bj][1];
#pragma unroll
                    for (int j = 0; j < 4; ++j) { v0[j] = g0[j] * sigmoid_f(v0[j]); v1[j] = g1[j] * sigmoid_f(v1[j]); }
                    *(u32x4*)(YS + (size_t)row * YSW + MW + col0 + bj * HALF) = pack8(v0, v1);
                }
            }
    }
};
struct EpiBranch {
    static constexpr bool PERM = true, AFTER_DRAIN = false, RESCALE = true, TWICE = false;
    const bf16_t* P; bf16_t* Mg;
    __device__ __forceinline__ void rescale(f32x4 (&acc)[2][2][4][2], const Unit& u, int seg, int wr, int wc, int fr, int fq) const {
        const int row0 = u.pm * BM + wr * 64 + fr, col0 = u.pn * BM + wc * 32 + 8 * fq;
#pragma unroll
        for (int ai = 0; ai < 2; ++ai)
#pragma unroll
            for (int mh = 0; mh < 2; ++mh) {
                u32x4 gp[2][2], gn[2][2];
#pragma unroll
                for (int mm = 0; mm < 2; ++mm)
#pragma unroll
                    for (int bj = 0; bj < 2; ++bj) { const bf16_t* q = P + (size_t)(row0 + ai * HALF + (2 * mh + mm) * 16) * (3 * D) + (seg - 1) * D + col0 + bj * HALF; gp[mm][bj] = *(const u32x4*)q; gn[mm][bj] = *(const u32x4*)(q + D); }
#pragma unroll
                for (int mm = 0; mm < 2; ++mm)
#pragma unroll
                    for (int bj = 0; bj < 2; ++bj) { const int m = 2 * mh + mm; f32x4 a0, a1, b0, b1; unpack8(gp[mm][bj], a0, a1); unpack8(gn[mm][bj], b0, b1);
#pragma unroll
                        for (int j = 0; j < 4; ++j) { acc[ai][bj][m][0][j] *= a0[j] * __builtin_amdgcn_rcpf(b0[j]); acc[ai][bj][m][1][j] *= a1[j] * __builtin_amdgcn_rcpf(b1[j]); } }
                asm volatile("" ::: "memory");
            }
    }
    __device__ __forceinline__ void operator()(const f32x4 (&acc)[2][2][4][2], const Unit& u, int wr, int wc, int fr, int fq) const {
        const int row0 = u.pm * BM + wr * 64 + fr, col0 = u.pn * BM + wc * 32 + 8 * fq;
#pragma unroll
        for (int ai = 0; ai < 2; ++ai)
#pragma unroll
            for (int m = 0; m < 4; ++m) {
                const int row = row0 + ai * HALF + m * 16;
#pragma unroll
                for (int bj = 0; bj < 2; ++bj) {
                    f32x4 g0, g1; unpack8(*(const u32x4*)(P + (size_t)row * (3 * D) + 2 * D + col0 + bj * HALF), g0, g1);
                    *(u32x4*)(Mg + (size_t)row * D + col0 + bj * HALF) = pack8(acc[ai][bj][m][0] * g0, acc[ai][bj][m][1] * g1);
                }
            }
    }
};
struct EpiResN {
    static constexpr bool PERM = true, AFTER_DRAIN = false, RESCALE = false, TWICE = false;
    const float* base32; const bf16_t* baseb; bf16_t* XB; float* X32; float* rsq;
    __device__ __forceinline__ void rescale(f32x4 (&)[2][2][4][2], const Unit&, int, int, int, int, int) const {}
    template <bool B32, bool O32> __device__ __forceinline__ void run(const f32x4 (&acc)[2][2][4][2], const Unit& u, int wr, int wc, int fr, int fq) const {
        const int row0 = u.pm * BM + wr * 64 + fr, col0 = u.pn * BM + wc * 32 + 8 * fq;
#pragma unroll
        for (int ai = 0; ai < 2; ++ai)
#pragma unroll
            for (int m = 0; m < 4; ++m) {
                const int row = row0 + ai * HALF + m * 16; const size_t off = (size_t)row * D + col0; float ss = 0.f;
#pragma unroll
                for (int bj = 0; bj < 2; ++bj) {
                    const size_t o = off + bj * HALF; f32x4 x0, x1;
                    if (B32) { x0 = *(const f32x4*)(base32 + o); x1 = *(const f32x4*)(base32 + o + 4); } else unpack8(*(const u32x4*)(baseb + o), x0, x1);
                    x0 = x0 + acc[ai][bj][m][0]; x1 = x1 + acc[ai][bj][m][1];
                    if (O32) { *(f32x4*)(X32 + o) = x0; *(f32x4*)(X32 + o + 4) = x1; }
                    ss += (x0[0] * x0[0] + x0[1] * x0[1]) + (x0[2] * x0[2] + x0[3] * x0[3]) + (x1[0] * x1[0] + x1[1] * x1[1]) + (x1[2] * x1[2] + x1[3] * x1[3]);
                    *(u32x4*)(XB + o) = pack8(x0, x1);
                }
                ss += __shfl_xor(ss, 16); ss += __shfl_xor(ss, 32);
                if (fq == 0) rsq[(size_t)row * 32 + u.pn * 4 + wc] = ss;
            }
    }
    __device__ __forceinline__ void operator()(const f32x4 (&acc)[2][2][4][2], const Unit& u, int wr, int wc, int fr, int fq) const {
        if (base32) run<true, false>(acc, u, wr, wc, fr, fq); else if (X32) run<false, true>(acc, u, wr, wc, fr, fq); else run<false, false>(acc, u, wr, wc, fr, fq);
    }
};
struct EpiRelu2 {
    static constexpr bool PERM = true, AFTER_DRAIN = false, RESCALE = false, TWICE = (MK_DUP == 38);
    bf16_t* Hd; const float* rsq; const PG8_LAS float* tab; int pm0;
    __device__ __forceinline__ void rescale(f32x4 (&)[2][2][4][2], const Unit&, int, int, int, int, int) const {}
    __device__ __forceinline__ void operator()(const f32x4 (&acc)[2][2][4][2], const Unit& u, int wr, int wc, int fr, int fq) const {
        const int row0 = u.pm * BM + wr * 64 + fr, col0 = u.pn * BM + wc * 32 + 8 * fq;
#pragma unroll
        for (int ai = 0; ai < 2; ++ai)
#pragma unroll
            for (int m = 0; m < 4; ++m) {
                bf16_t* rowp = Hd + (size_t)(row0 + ai * HALF + m * 16) * DFF + col0; const float rs = row_rstd(rsq, tab, pm0, u.pm, wr * 64 + fr + ai * HALF + m * 16);
#pragma unroll
                for (int bj = 0; bj < 2; ++bj) {
                    f32x4 v0 = acc[ai][bj][m][0] * rs, v1 = acc[ai][bj][m][1] * rs;
#pragma unroll
                    for (int j = 0; j < 4; ++j) { const float a = fmaxf(v0[j], 0.f), c = fmaxf(v1[j], 0.f); v0[j] = a * a; v1[j] = c * c; }
                    *(u32x4*)(rowp + bj * HALF) = pack8(v0, v1);
                }
            }
    }
};
template <class Epi, class Sched, bool ALIGN_EPI = false, bool SP2 = false>
__device__ __forceinline__ void gemm_phase(PG8_LAS unsigned char* lds, const Gemm g, const Sched& S, const Epi& E, const int tid_in) {
    int tid_l = tid_in; asm volatile("" : "+v"(tid_l));
    const int tid = tid_l, wid = __builtin_amdgcn_readfirstlane(tid >> 6), lane = tid & 63, wr = wid >> 2, wc = wid & 3, fr = lane & 15, fq = lane >> 4;
    const int K = g.K, nt = K / BK;
    unsigned voffA[2], voffB[2];
#pragma unroll
    for (int i = 0; i < 2; ++i) { int R, C; stage_rc(tid * 16 + i * 8192, R, C); const int Rb = Epi::PERM ? ((R & ~31) + perm32(R & 31)) : R;
        voffA[i] = (unsigned)(R * K + C) * 2u; voffB[i] = (unsigned)(Rb * K + C) * 2u; }
    const size_t kstep = (size_t)(BK * 2);
    const size_t hstep = (size_t)HALF * K * 2;
    const size_t tstep = 2 * hstep;
    const unsigned ldsw = (unsigned)wid * 1024u;
    const int aoff = lds_byte(wr * 64 + fr, fq * 8), boff = lds_byte(wc * 32 + fr, fq * 8);
#define PG8_SA(b, h) (((b) * 2 + (h)) * HTB)
#define PG8_SB(b, h) ((4 + (b) * 2 + (h)) * HTB)
#define PG8_STAGE(bufoff, gbase, voff) do { _Pragma("unroll") for (int _i = 0; _i < 2; ++_i) \
        __builtin_amdgcn_global_load_lds((const unsigned*)((const char*)(gbase) + (voff)[_i]), (PG8_LAS unsigned*)(lds + (bufoff) + ldsw + _i * 8192), 16, 0, 0); } while (0)
#define PG8_LDA(dst, b, h) do { _Pragma("unroll") for (int m = 0; m < 4; ++m) _Pragma("unroll") for (int k = 0; k < 2; ++k) dst[m][k] = *(const PG8_LAS bf16x8*)(lds + PG8_SA(b, h) + aoff + m * 2048 + k * 1024); } while (0)
#define PG8_LDB(dst, b, h) do { _Pragma("unroll") for (int n = 0; n < 2; ++n) _Pragma("unroll") for (int k = 0; k < 2; ++k) dst[n][k] = *(const PG8_LAS bf16x8*)(lds + PG8_SB(b, h) + boff + n * 2048 + k * 1024); } while (0)
#define PG8_MMA(ai, bj, At, Bt) do { __builtin_amdgcn_s_setprio(1); _Pragma("unroll") for (int m = 0; m < 4; ++m) _Pragma("unroll") for (int n = 0; n < 2; ++n) _Pragma("unroll") for (int k = 0; k < 2; ++k) \
        acc[ai][bj][m][n] = __builtin_amdgcn_mfma_f32_16x16x32_bf16(Bt[n][k], At[m][k], acc[ai][bj][m][n], 0, 0, 0); __builtin_amdgcn_s_setprio(0); } while (0)
#define PG8_WAIT_V(n) asm volatile("s_waitcnt vmcnt(" #n ")" ::: "memory")
#define PG8_WAIT_L(n) asm volatile("s_waitcnt lgkmcnt(" #n ")" ::: "memory")
#define PG8_BAR __builtin_amdgcn_s_barrier()
#define PG8_SCHED __builtin_amdgcn_sched_barrier(0)
    Unit cur, nxt; int ui = 0;
    if (!S.next(0, cur)) return;
    f32x4 acc[2][2][4][2];
#pragma unroll
    for (int a = 0; a < 2; ++a)
#pragma unroll
        for (int b = 0; b < 2; ++b)
#pragma unroll
            for (int m = 0; m < 4; ++m)
#pragma unroll
                for (int n = 0; n < 2; ++n) acc[a][b][m][n] = (f32x4){0.f, 0.f, 0.f, 0.f};
    bf16x8 At[4][2], B0[2][2], B1[2][2];
    const char* cA = (const char*)g.A + (size_t)cur.pm * tstep; const char* cB = (const char*)g.Bt + (size_t)cur.pn * tstep;
    S.a_ready(cur);
    if constexpr (SP2) {
        PG8_STAGE(PG8_SB(0, 0), cB, voffB); PG8_STAGE(PG8_SB(0, 1), cB + hstep, voffB); PG8_STAGE(PG8_SA(0, 0), cA, voffA); PG8_STAGE(PG8_SA(0, 1), cA + hstep, voffA);
        if (wr == 1) PG8_BAR;
        PG8_WAIT_V(2); PG8_BAR;
        PG8_STAGE(PG8_SB(1, 0), cB + kstep, voffB); PG8_STAGE(PG8_SA(1, 0), cA + kstep, voffA); PG8_STAGE(PG8_SB(1, 1), cB + hstep + kstep, voffB);
        PG8_WAIT_V(6); PG8_BAR;
    } else {
        PG8_STAGE(PG8_SB(0, 0), cB, voffB); PG8_STAGE(PG8_SA(0, 0), cA, voffA); PG8_STAGE(PG8_SB(0, 1), cB + hstep, voffB); PG8_STAGE(PG8_SA(0, 1), cA + hstep, voffA);
        if (wr == 1) PG8_BAR;
        PG8_WAIT_V(4); PG8_BAR;
        PG8_STAGE(PG8_SB(1, 0), cB + kstep, voffB); PG8_STAGE(PG8_SA(1, 0), cA + kstep, voffA); PG8_STAGE(PG8_SB(1, 1), cB + hstep + kstep, voffB);
        PG8_WAIT_V(6); PG8_BAR;
    }
    for (;;) {
        const bool has_next = S.next(ui + 1, nxt);
        const char* nA = has_next ? (const char*)g.A + (size_t)nxt.pm * tstep : cA; const char* nB = has_next ? (const char*)g.Bt + (size_t)nxt.pn * tstep : cB;
        for (int t = 0; t < nt; t += 2) {
            const bool last = (t == nt - 2);
            const char* a1 = cA + (size_t)(t + 1) * kstep;
            const char* a2 = last ? nA : cA + (size_t)(t + 2) * kstep; const char* b2 = last ? nB : cB + (size_t)(t + 2) * kstep;
            const char* a3 = a2 + kstep; const char* b3 = b2 + kstep;
            if (last && has_next) S.a_ready(nxt);
            if constexpr (SP2) {
            PG8_LDB(B0, 0, 0); PG8_LDB(B1, 0, 1); PG8_SCHED; PG8_LDA(At, 0, 0); PG8_STAGE(PG8_SA(1, 1), a1 + hstep, voffA);
            PG8_WAIT_V(8); PG8_WAIT_L(0); PG8_BAR; PG8_MMA(0, 0, At, B0); PG8_MMA(0, 1, At, B1); PG8_BAR; PG8_SCHED;
            PG8_LDA(At, 0, 1); PG8_STAGE(PG8_SB(0, 0), b2, voffB); PG8_STAGE(PG8_SB(0, 1), b2 + hstep, voffB); PG8_STAGE(PG8_SA(0, 0), a2, voffA);
            PG8_WAIT_V(8); PG8_WAIT_L(0); PG8_BAR; PG8_MMA(1, 0, At, B0); PG8_MMA(1, 1, At, B1); PG8_BAR; PG8_SCHED;
            PG8_LDB(B0, 1, 0); PG8_LDB(B1, 1, 1); PG8_SCHED; PG8_LDA(At, 1, 0); PG8_STAGE(PG8_SA(0, 1), a2 + hstep, voffA);
            PG8_WAIT_V(8); PG8_WAIT_L(0); PG8_BAR; PG8_MMA(0, 0, At, B0); PG8_MMA(0, 1, At, B1); PG8_BAR; PG8_SCHED;
            PG8_LDA(At, 1, 1); PG8_STAGE(PG8_SB(1, 0), b3, voffB); PG8_STAGE(PG8_SB(1, 1), b3 + hstep, voffB); PG8_STAGE(PG8_SA(1, 0), a3, voffA);
            PG8_WAIT_V(8); PG8_WAIT_L(0); PG8_BAR; PG8_MMA(1, 0, At, B0); PG8_MMA(1, 1, At, B1); PG8_BAR; PG8_SCHED;
            } else {
            PG8_LDB(B0, 0, 0); PG8_SCHED; PG8_LDA(At, 0, 0); PG8_STAGE(PG8_SA(1, 1), a1 + hstep, voffA);
            PG8_WAIT_L(8); PG8_BAR; PG8_WAIT_L(0); PG8_MMA(0, 0, At, B0); PG8_BAR; PG8_SCHED;
            PG8_LDB(B1, 0, 1); PG8_STAGE(PG8_SB(0, 0), b2, voffB);
            PG8_BAR; PG8_WAIT_L(0); PG8_MMA(0, 1, At, B1); PG8_BAR;
            PG8_LDA(At, 0, 1); PG8_STAGE(PG8_SA(0, 0), a2, voffA);
            PG8_BAR; PG8_WAIT_L(0); PG8_MMA(1, 0, At, B0); PG8_BAR; PG8_SCHED;
            PG8_STAGE(PG8_SB(0, 1), b2 + hstep, voffB);
            PG8_WAIT_V(6); PG8_BAR; PG8_MMA(1, 1, At, B1); PG8_BAR;
            PG8_LDB(B0, 1, 0); PG8_SCHED; PG8_LDA(At, 1, 0); PG8_STAGE(PG8_SA(0, 1), a2 + hstep, voffA);
            PG8_WAIT_L(8); PG8_BAR; PG8_WAIT_L(0); PG8_MMA(0, 0, At, B0); PG8_BAR; PG8_SCHED;
            PG8_LDB(B1, 1, 1); PG8_STAGE(PG8_SB(1, 0), b3, voffB);
            PG8_BAR; PG8_WAIT_L(0); PG8_MMA(0, 1, At, B1); PG8_BAR;
            PG8_LDA(At, 1, 1); PG8_STAGE(PG8_SA(1, 0), a3, voffA);
            PG8_BAR; PG8_WAIT_L(0); PG8_MMA(1, 0, At, B0); PG8_BAR; PG8_SCHED;
            PG8_STAGE(PG8_SB(1, 1), b3 + hstep, voffB);
            PG8_WAIT_V(6); PG8_BAR; PG8_MMA(1, 1, At, B1); PG8_BAR;
            }
            if constexpr (Epi::RESCALE) { if ((((t + 2) & 15) == 0) && (t + 2 < nt)) E.rescale(acc, cur, (t + 2) >> 4, wr, wc, fr, fq); }
        }
        if constexpr (ALIGN_EPI) { if (wr == 0) PG8_BAR; }
        if constexpr (!Epi::AFTER_DRAIN) { E(acc, cur, wr, wc, fr, fq); if constexpr (Epi::TWICE) { asm volatile("" ::: "memory"); E(acc, cur, wr, wc, fr, fq); } S.done(cur); }
        if (!has_next) break;
#pragma unroll
        for (int a = 0; a < 2; ++a)
#pragma unroll
            for (int b = 0; b < 2; ++b)
#pragma unroll
                for (int m = 0; m < 4; ++m)
#pragma unroll
                    for (int n = 0; n < 2; ++n) acc[a][b][m][n] = (f32x4){0.f, 0.f, 0.f, 0.f};
        cur = nxt; cA = nA; cB = nB; ++ui;
        if constexpr (ALIGN_EPI) { if (wr == 1) PG8_BAR; }
    }
    PG8_WAIT_V(0);
    if constexpr (!ALIGN_EPI) { if (wr == 0) PG8_BAR; }
    PG8_BAR;
    if constexpr (Epi::AFTER_DRAIN) { E.fused(acc, cur, wr, wc, fr, fq, lds, wid, lane); S.done(cur); }
#undef PG8_SA
#undef PG8_SB
#undef PG8_STAGE
#undef PG8_LDA
#undef PG8_LDB
#undef PG8_MMA
#undef PG8_WAIT_V
#undef PG8_WAIT_L
#undef PG8_BAR
#undef PG8_SCHED
}
}
#define XB_TMO      128
#define XB_XCNT(j)  (256  + 64 * (j))
#define XB_XSUB(j)  (1280 + 64 * (j))
#define XB_XGEN(j)  (2304 + 64 * (j))
#define XB_TOP      3328
#define XB_TOPGEN   3392
#define XCD_BAR_WORDS 3456
#define XB_SPIN_CAP (1u << 18)
#define LAS __attribute__((address_space(3)))

__device__ __forceinline__ unsigned xb_ld(unsigned* p)              { return __hip_atomic_load(p, __ATOMIC_RELAXED, __HIP_MEMORY_SCOPE_AGENT); }
__device__ __forceinline__ unsigned xb_add(unsigned* p, unsigned v) { return __hip_atomic_fetch_add(p, v, __ATOMIC_RELAXED, __HIP_MEMORY_SCOPE_AGENT); }
__device__ __forceinline__ unsigned xb_xcc_id() { return (unsigned)__builtin_amdgcn_s_getreg((3 << 11) | 20) & 0xFu; }
#define XB_SPIN(cond, bar) do { unsigned _sp = 0; while (cond) { __builtin_amdgcn_s_sleep(1); \
    if ((++_sp & 255u) == 0u) { if (xb_ld(&(bar)[XB_TMO])) break; if (_sp > XB_SPIN_CAP) { atomicAdd(&(bar)[XB_TMO], 1u); break; } } } } while (0)

struct XcdBarrier {
    unsigned* bar; unsigned x;
    volatile LAS unsigned* st;
};

__device__ __forceinline__ XcdBarrier xcd_barrier_post(unsigned* bar, volatile LAS unsigned* st) {
    XcdBarrier b; b.bar = bar; b.x = xb_xcc_id(); b.st = st;
    if (threadIdx.x == 0) (void)xb_add(&bar[XB_XCNT(b.x)], 1u);
    return b;
}
__device__ __forceinline__ void xcd_barrier_complete(unsigned* bar, unsigned x, unsigned& nloc, unsigned& nx) {
    const unsigned G = gridDim.x * gridDim.y * gridDim.z;
    unsigned sum, cnt, mine, sp = 0u;
    for (;;) {
        sum = 0u; cnt = 0u; mine = 0u;
#pragma unroll
        for (unsigned j = 0; j < 16; ++j) { const unsigned c = xb_ld(&bar[XB_XCNT(j)]); sum += c; cnt += (c > 0u) ? 1u : 0u; mine = (j == x) ? c : mine; }
        if (sum == G) break;
        __builtin_amdgcn_s_sleep(1);
        if ((++sp & 255u) == 0u) { if (xb_ld(&bar[XB_TMO])) break; if (sp > XB_SPIN_CAP) { atomicAdd(&bar[XB_TMO], 1u); break; } }
    }
    nloc = mine > 0u ? mine : 1u; nx = cnt > 0u ? cnt : 1u;
}

__device__ __forceinline__ void xcd_barrier(const XcdBarrier& b, const bool t0  ) {
    asm volatile("s_waitcnt vmcnt(0)" ::: "memory");
    __syncthreads();
    if (t0) {
        unsigned* bar = b.bar;
        __builtin_amdgcn_s_waitcnt(0);
        unsigned nloc = b.st[0], nx = b.st[1];
        if (nloc == 0u) { xcd_barrier_complete(bar, b.x, nloc, nx); b.st[0] = nloc; b.st[1] = nx; }
        const unsigned old = xb_add(&bar[XB_XSUB(b.x)], 1u);
        const unsigned gen = old / nloc;
        if (old + 1u == (gen + 1u) * nloc) {
            __builtin_amdgcn_fence(__ATOMIC_RELEASE, "agent");
            asm volatile("s_waitcnt vmcnt(0)" ::: "memory");
            const unsigned og = xb_add(&bar[XB_TOP], 1u);
            const unsigned tg = og / nx;
            if (og + 1u == (tg + 1u) * nx) xb_add(&bar[XB_TOPGEN], 1u);
            else XB_SPIN(xb_ld(&bar[XB_TOPGEN]) == tg, bar);
            __builtin_amdgcn_fence(__ATOMIC_ACQUIRE, "agent");
            xb_add(&bar[XB_XGEN(b.x)], 1u);
            asm volatile("s_waitcnt vmcnt(0)" ::: "memory");
        } else {
            XB_SPIN(xb_ld(&bar[XB_XGEN(b.x)]) == gen, bar);
            __builtin_amdgcn_fence(__ATOMIC_ACQUIRE, "agent");
            asm volatile("s_waitcnt vmcnt(0)" ::: "memory");
        }
    }
    __syncthreads();
}
constexpr int NWAVES = 8, NTHR = 512;
constexpr int LDS_CTL_OFF = 139264;
constexpr int LDS_BYTES = 147456;
#define MFMA16(a, b, c) __builtin_amdgcn_mfma_f32_16x16x32_bf16((a), (b), (c), 0, 0, 0)
#define MFMA32(a, b, c) __builtin_amdgcn_mfma_f32_32x32x16_bf16((a), (b), (c), 0, 0, 0)
typedef short s16x4 __attribute__((ext_vector_type(4)));
__device__ __forceinline__ void lds_barrier() { asm volatile("s_waitcnt lgkmcnt(0)" ::: "memory"); __builtin_amdgcn_s_barrier(); asm volatile("" ::: "memory"); }
__device__ __forceinline__ int crow(int reg, int h) { return (reg & 3) + 8 * (reg >> 2) + 4 * h; }

__device__ __forceinline__ void tr_tile(const float* W, int N, bf16* WT, int ldo, int koff, LAS float* scr  , int k0, int n0, int lane, const float* gk = nullptr  ) {
    float v[64];
#pragma unroll
    for (int kk = 0; kk < 64; ++kk) v[kk] = __builtin_nontemporal_load(W + (size_t)(k0 + kk) * N + n0 + lane);
    if (gk) {
#pragma unroll
        for (int kk = 0; kk < 64; ++kk) v[kk] *= gk[k0 + kk];
    }
#pragma unroll
    for (int kk = 0; kk < 64; ++kk) scr[kk * 65 + lane] = v[kk];
    asm volatile("s_waitcnt lgkmcnt(0)" ::: "memory");
    const int c = lane & 7;
#pragma unroll
    for (int j = 0; j < 8; ++j) {
        const int n = (lane >> 3) + 8 * j; const LAS float* s = scr + (8 * c) * 65 + n;
        u32x4 o; o.x = pk2(s[0], s[65]); o.y = pk2(s[2 * 65], s[3 * 65]); o.z = pk2(s[4 * 65], s[5 * 65]); o.w = pk2(s[6 * 65], s[7 * 65]);
        *(u32x4*)(WT + (size_t)(n0 + n) * ldo + koff + k0 + 8 * c) = o;
    }
    asm volatile("s_waitcnt lgkmcnt(0)" ::: "memory");
}
struct ConvSrc { const float *w_in, *w_glu, *w_branch, *w_out, *w_mi, *w_mo, *g1, *g2; };
constexpr int CV_T_IN = 32 * 192, CV_T_GLU = 16 * 16, CV_T_BR = 3 * 16 * 32, CV_T_OUT = 32 * 32, CV_T_MI = 32 * 128, CV_T_MO = 128 * 32, CV_TL = CV_T_IN + CV_T_GLU + CV_T_BR + CV_T_OUT + CV_T_MI + CV_T_MO;
constexpr int CV_LATE = 7424;
__device__ __forceinline__ void conv_tile(const ConvSrc& S, unsigned char* ws, LAS float* scr, int l, int r, int lane) {
    unsigned char* wl = ws + WS_W + (size_t)l * WL_SIZE;
    if (r < CV_T_IN) { tr_tile(S.w_in + (size_t)l * D * PC, PC, (bf16*)(wl + WL_IN), D, 0, scr, (r / 192) * 64, (r % 192) * 64, lane, S.g1 + (size_t)l * D); return; } r -= CV_T_IN;
    if (r < CV_T_GLU) { tr_tile(S.w_glu + (size_t)l * MW * MW, MW, (bf16*)(wl + WL_GLU), MW, 0, scr, (r / 16) * 64, (r % 16) * 64, lane); return; } r -= CV_T_GLU;
    if (r < CV_T_BR) { const int n3 = r / 512, rr = r % 512; tr_tile(S.w_branch + ((size_t)l * 3 + n3) * MW * D, D, (bf16*)(wl + WL_BR), 3 * MW, n3 * MW, scr, (rr / 32) * 64, (rr % 32) * 64, lane); return; } r -= CV_T_BR;
    if (r < CV_T_OUT) { tr_tile(S.w_out + (size_t)l * D * D, D, (bf16*)(wl + WL_OUT), D, 0, scr, (r / 32) * 64, (r % 32) * 64, lane); return; } r -= CV_T_OUT;
    if (r < CV_T_MI) { tr_tile(S.w_mi + (size_t)l * D * DFF, DFF, (bf16*)(wl + WL_MI), D, 0, scr, (r / 128) * 64, (r % 128) * 64, lane, S.g2 + (size_t)l * D); return; } r -= CV_T_MI;
    tr_tile(S.w_mo + (size_t)l * DFF * D, D, (bf16*)(wl + WL_MO), DFF, 0, scr, (r / 32) * 64, (r % 32) * 64, lane);
}
__device__ __forceinline__ void phase_conv(const ConvSrc& S, unsigned char* ws, LAS unsigned char* lds, int gw, int ngw, int wave, int lane, int lo0, int hi0, int late) {
    LAS float* scr = (LAS float*)(lds + wave * 16640);
    const int n0 = hi0 - lo0, per = CV_TL - late, total = n0 + (DEPTH - 1) * per;
    for (int it = gw; it < total; it += ngw) {
        if (it < n0) conv_tile(S, ws, scr, 0, lo0 + it, lane);
        else { const int j = it - n0; conv_tile(S, ws, scr, 1 + j / per, late + j % per, lane); }
    }
}
__device__ __forceinline__ void phase_conv_late(const ConvSrc& S, unsigned char* ws, LAS unsigned char* lds, int l, int iw, int nw, int wave, int lane, int late) {
    LAS float* scr = (LAS float*)(lds + wave * 16640);
    for (int it = iw; it < late; it += nw) conv_tile(S, ws, scr, l, it, lane);
}

struct S5Src { const float *lre, *lim, *ldt, *bre, *bim, *cre, *cim, *dd; };
__device__ __forceinline__ void phase_s5prep(const S5Src& S, unsigned char* ws, LAS unsigned char* lds, int tid) {
    constexpr int PWP = 65;
    LAS f32x2* pw = (LAS f32x2*)(lds);
    LAS f32x2* Bb = (LAS f32x2*)(lds + 8848);
    LAS f32x2* Cc = (LAS f32x2*)(lds + 17040);
    LAS float* Km = (LAS float*)(lds + 25232);
    LAS f32x2* Ct = (LAS f32x2*)(lds + 41616);
    for (int item = blockIdx.x; item < DEPTH * 64; item += gridDim.x) {
        const int l = item >> 6, g = item & 63; unsigned char* wl = ws + WS_W + (size_t)l * WL_SIZE;
        bf16* Wst = (bf16*)(wl + WL_WST) + (size_t)g * 128 * 256; bf16* W2 = (bf16*)(wl + WL_W2) + (size_t)g * 256 * 384; float2* A16 = (float2*)(wl + WL_A16) + g * 64;
        __syncthreads();
        if (tid < 64) {
            const int p = tid; const float dt = expf(S.ldt[l * 64 + g]); const float lr = S.lre[(l * 64 + g) * 64 + p], li = S.lim[(l * 64 + g) * 64 + p];
            const f32x4* br4 = (const f32x4*)(S.bre + ((size_t)(l * 64 + g) * 64 + p) * 16); const f32x4* bi4 = (const f32x4*)(S.bim + ((size_t)(l * 64 + g) * 64 + p) * 16);
            const f32x4 x0 = br4[0], x1 = br4[1], x2 = br4[2], x3 = br4[3], y0 = bi4[0], y1 = bi4[1], y2 = bi4[2], y3 = bi4[3];
            const float mag = expf(lr * dt); float sn, cs; sincosf(li * dt, &sn, &cs);
            const float ar = mag * cs, ai = mag * sn; const float den = lr * lr + li * li; const float nr = ar - 1.f, ni = ai;
            const float kr = (nr * lr + ni * li) / den, ki = (ni * lr - nr * li) / den;
            float xr = 1.f, xi = 0.f; pw[p] = (f32x2){1.f, 0.f};
#pragma unroll 1
            for (int m = 1; m <= 16; ++m) { const float tr = xr * ar - xi * ai, ti = xr * ai + xi * ar; xr = tr; xi = ti; pw[m * PWP + p] = (f32x2){xr, xi}; }
#define S5P_B(q, X, Y) do { Bb[p * 16 + 4 * (q) + 0] = (f32x2){kr * X.x - ki * Y.x, kr * Y.x + ki * X.x}; Bb[p * 16 + 4 * (q) + 1] = (f32x2){kr * X.y - ki * Y.y, kr * Y.y + ki * X.y}; \
                Bb[p * 16 + 4 * (q) + 2] = (f32x2){kr * X.z - ki * Y.z, kr * Y.z + ki * X.z}; Bb[p * 16 + 4 * (q) + 3] = (f32x2){kr * X.w - ki * Y.w, kr * Y.w + ki * X.w}; } while (0)
            S5P_B(0, x0, y0); S5P_B(1, x1, y1); S5P_B(2, x2, y2); S5P_B(3, x3, y3);
#undef S5P_B
        } else {
            for (int e = tid - 64; e < 1024; e += NTHR - 64) { const f32x2 c = (f32x2){S.cre[(size_t)(l * 64 + g) * 1024 + e], S.cim[(size_t)(l * 64 + g) * 1024 + e]}; Cc[e] = c; Ct[(e & 63) * 16 + (e >> 6)] = c; }
        }
        __syncthreads();
        {
            const int c = tid & 255, m = c >> 4, h = c & 15, half = __builtin_amdgcn_readfirstlane(tid >> 8);
            float acc[8];
#pragma unroll
            for (int r = 0; r < 8; ++r) acc[r] = 0.f;
#pragma unroll 4
            for (int p = 0; p < 64; ++p) {
                const f32x2 a = pw[m * PWP + p], b = Bb[p * 16 + h]; const float xr = a.x * b.x - a.y * b.y, xi = a.x * b.y + a.y * b.x;
                const LAS f32x4* ct = (const LAS f32x4*)(Ct + p * 16 + half * 8);
#pragma unroll
                for (int q = 0; q < 4; ++q) { const f32x4 cq = ct[q]; acc[2 * q] += cq.x * xr - cq.y * xi; acc[2 * q + 1] += cq.z * xr - cq.w * xi; }
            }
            const float dv = S.dd[l * MW + g * 16 + h];
#pragma unroll
            for (int r = 0; r < 8; ++r) { const int hp = half * 8 + r; Km[(m * 16 + hp) * 16 + h] = acc[r] + ((m == 0 && hp == h) ? dv : 0.f); }
        }
        __syncthreads();
        for (int ge = tid; ge < 128 * 32; ge += NTHR) {
            const int o = ge >> 5, kk = (ge & 31) * 8, i = kk >> 4, h0 = kk & 15, p = o & 63; const f32x2 a = pw[(15 - i) * PWP + p];
            const LAS f32x4* b4 = (const LAS f32x4*)(Bb + p * 16 + h0); const f32x4 b0 = b4[0], b1 = b4[1], b2 = b4[2], b3 = b4[3];
            u32x4 w;
            if (o < 64) { w.x = pk2(a.x * b0.x - a.y * b0.y, a.x * b0.z - a.y * b0.w); w.y = pk2(a.x * b1.x - a.y * b1.y, a.x * b1.z - a.y * b1.w); w.z = pk2(a.x * b2.x - a.y * b2.y, a.x * b2.z - a.y * b2.w); w.w = pk2(a.x * b3.x - a.y * b3.y, a.x * b3.z - a.y * b3.w); }
            else        { w.x = pk2(a.x * b0.y + a.y * b0.x, a.x * b0.w + a.y * b0.z); w.y = pk2(a.x * b1.y + a.y * b1.x, a.x * b1.w + a.y * b1.z); w.z = pk2(a.x * b2.y + a.y * b2.x, a.x * b2.w + a.y * b2.z); w.w = pk2(a.x * b3.y + a.y * b3.x, a.x * b3.w + a.y * b3.z); }
            *(u32x4*)(Wst + (size_t)o * 256 + kk) = w;
        }
        for (int ge = tid; ge < 256 * 48; ge += NTHR) {
            const int o = ge / 48, k0 = (ge - o * 48) * 8, j = o >> 4, hp = o & 15; u32x4 w;
            if (k0 < 256) {
                const int i = k0 >> 4, h0 = k0 & 15;
                if (j >= i) { const LAS f32x4* k4 = (const LAS f32x4*)(Km + ((j - i) * 16 + hp) * 16 + h0); const f32x4 u = k4[0], v = k4[1]; w.x = pk2(u.x, u.y); w.y = pk2(u.z, u.w); w.z = pk2(v.x, v.y); w.w = pk2(v.z, v.w); }
                else w = (u32x4){0u, 0u, 0u, 0u};
            } else {
                const int pp = (k0 - 256) & 63; const bool im = k0 >= 320; const LAS f32x4* c4 = (const LAS f32x4*)(Cc + hp * 64 + pp); const LAS f32x2* a2 = pw + (j + 1) * PWP + pp;
                float r[8];
#pragma unroll
                for (int q = 0; q < 4; ++q) { const f32x4 cq = c4[q]; const f32x2 a0 = a2[2 * q], a1 = a2[2 * q + 1];
                    r[2 * q] = im ? -(cq.x * a0.y + cq.y * a0.x) : (cq.x * a0.x - cq.y * a0.y); r[2 * q + 1] = im ? -(cq.z * a1.y + cq.w * a1.x) : (cq.z * a1.x - cq.w * a1.y); }
                w.x = pk2(r[0], r[1]); w.y = pk2(r[2], r[3]); w.z = pk2(r[4], r[5]); w.w = pk2(r[6], r[7]);
            }
            *(u32x4*)(W2 + (size_t)o * 384 + k0) = w;
        }
        if (tid < 64) { const f32x2 q = pw[16 * PWP + tid]; A16[tid] = make_float2(q.x, q.y); }
    }
}

__device__ __forceinline__ void phase_rmsnorm_bf16(const float* x, const float* g, bf16* out, int gw, int ngw, int lane) {
    for (int row = gw; row < M; row += ngw) {
        const f32x4* xr = (const f32x4*)(x + (size_t)row * D) + lane; f32x4 v[8]; float s = 0.f;
#pragma unroll
        for (int j = 0; j < 8; ++j) { v[j] = xr[64 * j]; s += (v[j].x * v[j].x + v[j].y * v[j].y) + (v[j].z * v[j].z + v[j].w * v[j].w); }
        const float rstd = rsqrtf(wave_sum(s) * (1.f / D) + EPS);
        const f32x4* gr = (const f32x4*)g + lane; u32x2* o = (u32x2*)(out + (size_t)row * D) + lane;
#pragma unroll
        for (int j = 0; j < 8; ++j) { const f32x4 gg = gr[64 * j]; u32x2 w; w.x = pk2(v[j].x * rstd * gg.x, v[j].y * rstd * gg.y); w.y = pk2(v[j].z * rstd * gg.z, v[j].w * rstd * gg.w); o[64 * j] = w; }
    }
}
__device__ __forceinline__ void rstd_table(const float* rsq, int pm, LAS float* tab, int tid) {
    const f32x4* q = (const f32x4*)(rsq + (size_t)(pm * 256 + (tid >> 1)) * 32 + 16 * (tid & 1)); float s = 0.f;
#pragma unroll
    for (int i = 0; i < 4; ++i) { const f32x4 v = q[i]; s += (v[0] + v[1]) + (v[2] + v[3]); }
    s += __shfl_xor(s, 1);
    if (!(tid & 1)) tab[tid >> 1] = rsqrtf(s * (1.f / D) + EPS);
}
__device__ __forceinline__ void phase_norm0(const float* x, bf16* out, float* rsq, int gw, int ngw, int lane) {
    for (int row = gw; row < M; row += ngw) {
        const f32x4* xr = (const f32x4*)(x + (size_t)row * D) + lane; f32x4 v[8]; float s = 0.f;
#pragma unroll
        for (int j = 0; j < 8; ++j) { v[j] = xr[64 * j]; s += (v[j].x * v[j].x + v[j].y * v[j].y) + (v[j].z * v[j].z + v[j].w * v[j].w); }
        s = wave_sum(s); if (lane < 32) rsq[(size_t)row * 32 + lane] = lane == 0 ? s : 0.f;
        u32x2* o = (u32x2*)(out + (size_t)row * D) + lane;
#pragma unroll
        for (int j = 0; j < 8; ++j) { u32x2 w; w.x = pk2(v[j].x, v[j].y); w.y = pk2(v[j].z, v[j].w); o[64 * j] = w; }
    }
}
__device__ __forceinline__ void phase_rmsnorm_f32(const float* x, const float* g, float* out, int gw, int ngw, int lane) {
    for (int row = gw; row < M; row += ngw) {
        const f32x4* xr = (const f32x4*)(x + (size_t)row * D) + lane; f32x4 v[8]; float s = 0.f;
#pragma unroll
        for (int j = 0; j < 8; ++j) { v[j] = xr[64 * j]; s += (v[j].x * v[j].x + v[j].y * v[j].y) + (v[j].z * v[j].z + v[j].w * v[j].w); }
        const float rstd = rsqrtf(wave_sum(s) * (1.f / D) + EPS);
        const f32x4* gr = (const f32x4*)g + lane; f32x4* o = (f32x4*)(out + (size_t)row * D) + lane;
#pragma unroll
        for (int j = 0; j < 8; ++j) { const f32x4 gg = gr[64 * j]; o[64 * j] = (f32x4){v[j].x * rstd * gg.x, v[j].y * rstd * gg.y, v[j].z * rstd * gg.z, v[j].w * rstd * gg.w}; }
    }
}

constexpr int GM_VP = 160;
__device__ __forceinline__ void stage_gmlp(const bf16* U, const bf16* VG, const float* vsq, const float* gng, const float* wsl, const float* bsl, bf16* YS, LAS unsigned char* lds, int unit, int tid, int wave, int lane) {
    const int c = unit >> 3, g = unit & 7, row0 = c * 128;
    LAS float* rs = (LAS float*)lds;
    LAS bf16* Vt = (LAS bf16*)(lds + 512);
    lds_barrier();
    if (tid < 128) { const f32x4* q = (const f32x4*)(vsq + (size_t)(row0 + tid) * 16); const f32x4 a = q[0], b = q[1], cc = q[2], d = q[3];
        const float s = ((a.x + a.y) + (a.z + a.w)) + ((b.x + b.y) + (b.z + b.w)) + ((cc.x + cc.y) + (cc.z + cc.w)) + ((d.x + d.y) + (d.z + d.w)); rs[tid] = rsqrtf(s * (1.f / MW) + EPS); }
#pragma unroll
    for (int i = 0; i < 4; ++i) { const int idx = tid + NTHR * i, s = idx >> 4, cc = idx & 15; const u32x4 v = *(const u32x4*)(VG + (size_t)(row0 + s) * MW + g * 128 + 8 * cc); *(LAS u32x4*)(Vt + s * GM_VP + 8 * cc) = v; }
    lds_barrier();
    const int tq = wave >> 1, chh = wave & 1, r = lane & 31, hh = lane >> 5, t0 = 32 * tq, t = t0 + r;
    const int trl = ((lane & 15) >> 2) * GM_VP + 16 * ((lane >> 4) & 1) + 4 * (lane & 3);
    f32x16 acc[2];
#pragma unroll
    for (int i = 0; i < 16; ++i) { acc[0][i] = 0.f; acc[1][i] = 0.f; }
    for (int ks = 0; ks <= 2 * tq + 1; ++ks) {
        const int sb = 16 * ks + 8 * hh;
        const float* wp = wsl + (size_t)(g * 128 + t) * 128 + sb; const f32x4 w0 = *(const f32x4*)wp, w1 = *(const f32x4*)(wp + 4);
        const f32x4 r0 = *(const LAS f32x4*)(rs + sb), r1 = *(const LAS f32x4*)(rs + sb + 4);
        const float av[8] = {w0.x * r0.x, w0.y * r0.y, w0.z * r0.z, w0.w * r0.w, w1.x * r1.x, w1.y * r1.y, w1.z * r1.z, w1.w * r1.w};
        u32x4 bp;
#pragma unroll
        for (int j = 0; j < 4; ++j) { const float lo = (sb + 2 * j <= t) ? av[2 * j] : 0.f, hi = (sb + 2 * j + 1 <= t) ? av[2 * j + 1] : 0.f; bp[j] = pk2(lo, hi); }
        const bf16x8 bfrag = __builtin_bit_cast(bf16x8, bp);
#pragma unroll
        for (int ct = 0; ct < 2; ++ct) {
            const LAS bf16* vb = Vt + sb * GM_VP + 64 * chh + 32 * ct + trl;
            const s16x4 lo = __builtin_amdgcn_ds_read_tr16_b64_v4i16((LAS s16x4*)vb), hi = __builtin_amdgcn_ds_read_tr16_b64_v4i16((LAS s16x4*)(vb + 4 * GM_VP));
            acc[ct] = MFMA32(__builtin_shufflevector(lo, hi, 0, 1, 2, 3, 4, 5, 6, 7), bfrag, acc[ct]);
        }
    }
    const float bt = bsl[g * 128 + t];
#pragma unroll
    for (int ct = 0; ct < 2; ++ct)
#pragma unroll
        for (int gi = 0; gi < 4; ++gi) {
            const int ch = g * 128 + 64 * chh + 32 * ct + 8 * gi + 4 * hh; const f32x4 gn = *(const f32x4*)(gng + ch);
            const u32x2 uu = *(const u32x2*)(U + (size_t)(row0 + t) * MW + ch);
            u32x2 o; o.x = pk2(bflo(uu.x) * (gn[0] * acc[ct][4 * gi] + bt), bfhi(uu.x) * (gn[1] * acc[ct][4 * gi + 1] + bt)); o.y = pk2(bflo(uu.y) * (gn[2] * acc[ct][4 * gi + 2] + bt), bfhi(uu.y) * (gn[3] * acc[ct][4 * gi + 3] + bt));
            *(u32x2*)(YS + (size_t)(row0 + t) * YSW + ch) = o;
        }
}

constexpr int S5_PITCH = 784, S5_IMG_BYTES = 64 * S5_PITCH, S5_SL_OFF = 51200;
__device__ __forceinline__ void stage_s5(const bf16* SIN, const bf16* Wst_l, const bf16* W2_l, const float2* A16_l, bf16* G, LAS unsigned char* lds, int unit, int tid, int wave, int lane) {
    const int b = unit >> 6, g = unit & 63, fr = lane & 15, fq = lane >> 4;
    LAS unsigned char* img = lds; LAS float* Sl = (LAS float*)(lds + S5_SL_OFF);
    const bf16* wst = Wst_l + (size_t)g * 128 * 256; const bf16* w2 = W2_l + (size_t)g * 256 * 384;
    const bf16* uin = SIN + (size_t)(b * 64 + g) * SEQ * 16;
    bf16x8 wstf[8], w2f[2][12];
#pragma unroll
    for (int ks = 0; ks < 8; ++ks) wstf[ks] = *(const bf16x8*)(wst + (size_t)(16 * wave + fr) * 256 + 32 * ks + 8 * fq);
#pragma unroll
    for (int c2 = 0; c2 < 2; ++c2)
#pragma unroll
        for (int ks = 0; ks < 12; ++ks) w2f[c2][ks] = *(const bf16x8*)(w2 + (size_t)(16 * (2 * wave + c2) + fr) * 384 + 32 * ks + 8 * fq);
    const float2 a16 = A16_l[g * 64 + lane]; float sr = 0.f, si = 0.f;
    u32x4 ur[4];
#pragma unroll
    for (int i = 0; i < 4; ++i) ur[i] = *(const u32x4*)(uin + (size_t)(tid + NTHR * i) * 8);
    for (int q = 0; q < 4; ++q) {
        lds_barrier();
#pragma unroll
        for (int i = 0; i < 4; ++i) { const int idx = tid + NTHR * i; *(LAS u32x4*)(img + (idx >> 5) * S5_PITCH + (idx & 31) * 16) = ur[i]; }
        if (q < 3) {
#pragma unroll
            for (int i = 0; i < 4; ++i) ur[i] = *(const u32x4*)(uin + (size_t)(q + 1) * 16384 + (size_t)(tid + NTHR * i) * 8);
        }
        lds_barrier();
#pragma unroll
        for (int rt = 0; rt < 4; ++rt) {
            f32x4 acc = {0.f, 0.f, 0.f, 0.f};
#pragma unroll
            for (int ks = 0; ks < 8; ++ks) acc = MFMA16(*(const LAS bf16x8*)(img + (16 * rt + fr) * S5_PITCH + 64 * ks + 16 * fq), wstf[ks], acc);
#pragma unroll
            for (int jj = 0; jj < 4; ++jj) Sl[(16 * rt + 4 * fq + jj) * 128 + 16 * wave + fr] = acc[jj];
        }
        lds_barrier();
        if (wave == 0) {
#pragma unroll 1
            for (int cb = 0; cb < 64; cb += 16) {
                float xs[16], ys[16]; unsigned short er[16], ei[16];
#pragma unroll
                for (int c = 0; c < 16; ++c) { xs[c] = Sl[(cb + c) * 128 + lane]; ys[c] = Sl[(cb + c) * 128 + 64 + lane]; }
#pragma unroll
                for (int c = 0; c < 16; ++c) { er[c] = f2bf(sr); ei[c] = f2bf(si); const float nr = a16.x * sr - a16.y * si + xs[c], ni = a16.x * si + a16.y * sr + ys[c]; sr = nr; si = ni; }
#pragma unroll
                for (int c = 0; c < 16; ++c) { *(LAS bf16*)(img + (cb + c) * S5_PITCH + 512 + 2 * lane) = er[c]; *(LAS bf16*)(img + (cb + c) * S5_PITCH + 640 + 2 * lane) = ei[c]; }
            }
        }
        f32x4 yacc[4][2];
#pragma unroll
        for (int rt = 0; rt < 4; ++rt) {
            yacc[rt][0] = (f32x4){0.f, 0.f, 0.f, 0.f}; yacc[rt][1] = (f32x4){0.f, 0.f, 0.f, 0.f};
#pragma unroll
            for (int ks = 0; ks < 8; ++ks) { const bf16x8 af = *(const LAS bf16x8*)(img + (16 * rt + fr) * S5_PITCH + 64 * ks + 16 * fq);
                yacc[rt][0] = MFMA16(w2f[0][ks], af, yacc[rt][0]); yacc[rt][1] = MFMA16(w2f[1][ks], af, yacc[rt][1]); }
        }
        lds_barrier();
#pragma unroll
        for (int rt = 0; rt < 4; ++rt) {
#pragma unroll
            for (int ks = 8; ks < 12; ++ks) { const bf16x8 af = *(const LAS bf16x8*)(img + (16 * rt + fr) * S5_PITCH + 64 * ks + 16 * fq);
                yacc[rt][0] = MFMA16(w2f[0][ks], af, yacc[rt][0]); yacc[rt][1] = MFMA16(w2f[1][ks], af, yacc[rt][1]); }
#pragma unroll
            for (int c2 = 0; c2 < 2; ++c2) { const f32x4 v = yacc[rt][c2]; u32x2 o; o.x = pk2(gelu_t(v[0]), gelu_t(v[1])); o.y = pk2(gelu_t(v[2]), gelu_t(v[3]));
                *(u32x2*)(G + (size_t)(b * SEQ + 16 * (64 * q + 16 * rt + fr) + 2 * wave + c2) * MW + g * 16 + 4 * fq) = o; }
        }
    }
}

constexpr int ATT_VP = 160;
__device__ __forceinline__ void stage_attn(const bf16* Qb, const bf16* Kb, const bf16* Vb, bf16* YS, LAS unsigned char* lds, int unit, int wave, int lane) {
    const int b = unit >> 7, hd = (unit >> 4) & 7, qb = unit & 15, t0 = 256 * qb + 32 * wave, r = lane & 31, hh = lane >> 5;
    const size_t hoff = (size_t)(b * 8 + hd) * SEQ * 128; const bf16* Qh = Qb + hoff; const bf16* Kh = Kb + hoff; const bf16* Vh = Vb + hoff;
    LAS bf16* Vs = (LAS bf16*)(lds + wave * (32 * ATT_VP * 2));
    bf16x8 qf[8], kf[8]; u32x4 vr[8];
#pragma unroll
    for (int ks = 0; ks < 8; ++ks) qf[ks] = *(const bf16x8*)(Qh + (size_t)(t0 + r) * 128 + 16 * ks + 8 * hh);
#define ATT_LOAD(S0) do { _Pragma("unroll") for (int ks = 0; ks < 8; ++ks) kf[ks] = *(const bf16x8*)(Kh + (size_t)((S0) + r) * 128 + 16 * ks + 8 * hh); \
        _Pragma("unroll") for (int i = 0; i < 8; ++i) vr[i] = *(const u32x4*)(Vh + (size_t)((S0) + (lane >> 4) + 4 * i) * 128 + 8 * (lane & 15)); } while (0)
    ATT_LOAD(t0);
    f32x16 o[4];
#pragma unroll
    for (int dt = 0; dt < 4; ++dt)
#pragma unroll
        for (int i = 0; i < 16; ++i) o[dt][i] = 0.f;
    float C = 1.f;
    const float c1 = 0.08838834764831845f * 1.4426950408889634f;
    const int trl = ((lane & 15) >> 2) * ATT_VP + 16 * ((lane >> 4) & 1) + 4 * (lane & 3);
    for (int s0 = t0;;) {
#pragma unroll
        for (int i = 0; i < 8; ++i) *(LAS u32x4*)(Vs + ((lane >> 4) + 4 * i) * ATT_VP + 8 * (lane & 15)) = vr[i];
        asm volatile("" ::: "memory");
        f32x16 z;
#pragma unroll
        for (int i = 0; i < 16; ++i) z[i] = 0.f;
#pragma unroll
        for (int ks = 0; ks < 8; ++ks) z = MFMA32(kf[ks], qf[ks], z);
        const int sn = s0 - 32;
        if (sn >= 0) ATT_LOAD(sn);
        float be[16], om[16], w[16];
#pragma unroll
        for (int i = 0; i < 16; ++i) { const float zr = z[i]; const float e = __builtin_amdgcn_exp2f(-fabsf(zr) * c1); const float rc = __builtin_amdgcn_rcpf(1.f + e), er = e * rc; const bool pos = zr > 0.f; be[i] = pos ? rc : er; om[i] = pos ? er : rc; }
        if (s0 == t0) {
#pragma unroll
            for (int i = 0; i < 16; ++i) { const bool valid = crow(i, hh) < r; be[i] = valid ? be[i] : 0.f; om[i] = valid ? om[i] : 1.f; }
        }
        float gp[4], pgp[4], aft[4];
#pragma unroll
        for (int gi = 0; gi < 4; ++gi) { w[4 * gi + 3] = 1.f; w[4 * gi + 2] = om[4 * gi + 3]; w[4 * gi + 1] = om[4 * gi + 2] * w[4 * gi + 2]; w[4 * gi] = om[4 * gi + 1] * w[4 * gi + 1]; gp[gi] = om[4 * gi] * w[4 * gi]; pgp[gi] = __shfl_xor(gp[gi], 32); }
        float run = 1.f;
#pragma unroll
        for (int gi = 3; gi >= 0; --gi) { aft[gi] = (hh ? run : run * pgp[gi]) * C; run *= gp[gi] * pgp[gi]; }
#pragma unroll
        for (int i = 0; i < 16; ++i) w[i] = be[i] * w[i] * aft[i >> 2];
        C *= run;
#pragma unroll
        for (int s = 0; s < 2; ++s) {
            u32x4 wp;
#pragma unroll
            for (int j = 0; j < 4; ++j) wp[j] = pk2(w[8 * s + 2 * j], w[8 * s + 2 * j + 1]);
            const bf16x8 wf = __builtin_bit_cast(bf16x8, wp);
#pragma unroll
            for (int dt = 0; dt < 4; ++dt) {
                const LAS bf16* vb = Vs + (16 * s + 4 * hh) * ATT_VP + 32 * dt + trl;
                const s16x4 lo = __builtin_amdgcn_ds_read_tr16_b64_v4i16((LAS s16x4*)vb), hi = __builtin_amdgcn_ds_read_tr16_b64_v4i16((LAS s16x4*)(vb + 8 * ATT_VP));
                o[dt] = MFMA32(__builtin_shufflevector(lo, hi, 0, 1, 2, 3, 4, 5, 6, 7), wf, o[dt]);
            }
        }
        if (sn < 0 || __all(C == 0.f)) break;
        s0 = sn;
    }
#undef ATT_LOAD
    bf16* orow = YS + (size_t)(b * SEQ + t0 + r) * YSW + 2 * MW + hd * 128;
#pragma unroll
    for (int dt = 0; dt < 4; ++dt)
#pragma unroll
        for (int gi = 0; gi < 4; ++gi) { u32x2 v; v.x = pk2(o[dt][4 * gi], o[dt][4 * gi + 1]); v.y = pk2(o[dt][4 * gi + 2], o[dt][4 * gi + 3]); *(u32x2*)(orow + 32 * dt + 8 * gi + 4 * hh) = v; }
}
#ifndef MK_DUP
#define MK_DUP -1
#endif
#define REP(k) for (int rep_ = 0; rep_ < ((MK_DUP) == (k) ? 2 : 1); ++rep_)
#ifndef STAG_NG
#define STAG_NG 1
#endif
#ifndef STAG_US
#define STAG_US 0
#endif
#define STAGGER() do { if (STAG_NG > 1) { const unsigned long long t0_ = __builtin_amdgcn_s_memrealtime(), dl_ = (unsigned long long)((bid >> 3) % STAG_NG) * (STAG_US) * 100ull; while (__builtin_amdgcn_s_memrealtime() - t0_ < dl_) __builtin_amdgcn_s_sleep(32); } } while (0)
#ifndef MK_SUB
#define MK_SUB 7
#endif
#ifndef MK_DIAG
#define MK_DIAG -1
#endif
#ifndef MK_DIAGV
#define MK_DIAGV 0
#endif
#ifndef MK_DIAGL
#define MK_DIAGL 0
#endif
#define DSTAMP(k, w) do { if (MK_DIAG == (k) && tid == 0) ((unsigned long long*)(ws + WS_SALL + 128 * MiB))[(w) * 256 + bid] = __builtin_amdgcn_s_memrealtime(); } while (0)
#define DSTAMPL(k, w) do { if (l == MK_DIAGL) DSTAMP(k, w); } while (0)
#ifndef MK_ONLY_PRO
#define MK_ONLY_PRO 1
#endif
#ifndef MK_ONLY_FIN
#define MK_ONLY_FIN 1
#endif
struct Args { const float* in[23]; float* out; unsigned char* ws; int l_lo, l_hi, ph_lo, ph_hi, pro, fin; };
constexpr int NPH = 10;
__global__ void __launch_bounds__(NTHR, 2) mk_fwd(Args a) {
    extern __shared__ __attribute__((aligned(16))) unsigned char lds_raw[];
    LAS unsigned char* lds = (LAS unsigned char*)lds_raw;
    const int wave_s = __builtin_amdgcn_readfirstlane(threadIdx.x >> 6);
    const int G = gridDim.x, ngw = G * NWAVES;
    unsigned char* ws = a.ws;
    for (int u = threadIdx.x; u < (LDS_BYTES - LDS_CTL_OFF) / 4; u += NTHR) ((LAS unsigned*)(lds + LDS_CTL_OFF))[u] = 0u;
    __syncthreads();
    XcdBarrier bar = xcd_barrier_post((unsigned*)(ws + WS_CTL), (volatile LAS unsigned*)(lds + LDS_CTL_OFF));
    float* X = (float*)(ws + WS_X); bf16* H = (bf16*)(ws + WS_H); bf16* P = (bf16*)(ws + WS_PROJ); unsigned char* pj = ws + WS_PROJ; bf16* Gb = (bf16*)(ws + WS_G); bf16* YS = (bf16*)(ws + WS_YS);
    bf16* MG = (bf16*)(ws + WS_MERGED); bf16* HID = (bf16*)(ws + WS_HID); float* VSQ = (float*)(ws + WS_VSQ); float* RSQa = (float*)(ws + WS_RSQ); float* RSQb = RSQa + (size_t)M * 32; bf16* SST = (bf16*)(ws + WS_SST);

#define LAUNDER() int lane_l, wave_l = wave_s, bid_l = blockIdx.x; asm volatile("v_mbcnt_lo_u32_b32 %0, -1, 0\n\tv_mbcnt_hi_u32_b32 %0, -1, %0" : "=v"(lane_l)); asm volatile("" : "+s"(wave_l), "+s"(bid_l)); const int lane = lane_l, wave = wave_l, bid = bid_l, tid = wave_l * 64 + lane_l, gw = bid_l * NWAVES + wave_l; (void)tid; (void)lane; (void)wave; (void)gw; (void)bid
    if ((MK_ONLY_PRO) && a.pro) REP(100) {
        LAUNDER();
        DSTAMP(3, 0); DSTAMP(4, 0);
        const ConvSrc cs{a.in[2], a.in[15], a.in[17], a.in[18], a.in[20], a.in[21], a.in[1], a.in[19]};
        if (G == 256) phase_conv(cs, ws, lds, gw, ngw, wave, lane, 0, CV_T_IN, CV_TL);
        else phase_conv(cs, ws, lds, gw, ngw, wave, lane, 0, CV_TL, 0);
        DSTAMP(4, 1); DSTAMP(5, 0);
        const S5Src ss{a.in[7], a.in[8], a.in[9], a.in[10], a.in[11], a.in[12], a.in[13], a.in[14]};
        phase_s5prep(ss, ws, lds, tid);
        DSTAMP(5, 1); DSTAMP(6, 0);
        phase_norm0(a.in[0], H, RSQb, gw, ngw, lane);
        DSTAMP(6, 1);
        xcd_barrier(bar, tid == 0);
        DSTAMP(3, 1);
    }
    for (int l = a.l_lo; l < a.l_hi; ++l) {
        unsigned char* wl = ws + WS_W + (size_t)l * WL_SIZE;
        const float* xsrc = (l == 0) ? a.in[0] : X;
#ifndef MK_ONLY
#define MK_ONLY -1
#endif
#ifndef MK_MASK
#define MK_MASK 0x3ff
#endif
#define IN(k) ((MK_ONLY < 0 || MK_ONLY == (k)) && ((MK_MASK >> (k)) & 1) && a.ph_lo <= (k) && (k) < a.ph_hi)
        if (IN(1)) REP(1) {
            LAUNDER();
            pg8::Gemm g{H, (const bf16*)(wl + WL_IN), M, PC, D}; pg8::StaticOrder S; S.init(M, PC, G, bid);
            LAS float* tab = (LAS float*)(lds + 131072); pg8::Unit u0; int pm0 = -1; if (S.next(0, u0)) { pm0 = u0.pm; rstd_table(RSQb, pm0, tab, tid); } __syncthreads();
            pg8::EpiProj E{P, a.in[3] + (size_t)l * 3 * D, VSQ, RSQb, tab, pm0};
            DSTAMPL(1, 0);
            const int cpos = (l == 0 && G == 256) ? ((bid & 7) < 6 ? (bid & 7) : 6) : -1;
#pragma unroll 1
            for (int part = 0; part < 2; ++part) {
                LAUNDER();
                if (part) {
                    if (cpos < 0) break;
                    const ConvSrc cs{a.in[2], a.in[15], a.in[17], a.in[18], a.in[20], a.in[21], a.in[1], a.in[19]};
                    DSTAMPL(2, 0);
                    phase_conv(cs, ws, lds, gw, ngw, wave, lane, CV_T_IN, CV_TL, CV_LATE);
                    DSTAMPL(2, 1);
                    __syncthreads(); if (pm0 >= 0) rstd_table(RSQb, pm0, tab, tid); __syncthreads();
                }
                pg8::SubOrder SS{S, part ? cpos : 0, (part || cpos < 0) ? (1 << 20) : cpos};
                pg8::gemm_phase<pg8::EpiProj, pg8::SubOrder, true, true>(lds, g, SS, E, tid);
            }
            { LAUNDER(); DSTAMPL(1, 1); }
            xcd_barrier(bar, tid == 0);
        }
        if (IN(2)) REP(2) {
            LAUNDER();
            const bool attn_first = (G == 256) && bid >= 128;
#define MIX_ATTN() do { if (MK_SUB & 4) REP(22) for (int u = bid; u < 256; u += G) stage_attn((const bf16*)(pj + PJ_Q), (const bf16*)(pj + PJ_K), (const bf16*)(pj + PJ_V), YS, lds, u, wave, lane); } while (0)
            if (attn_first) { lds_barrier(); MIX_ATTN(); lds_barrier(); }
            if (MK_SUB & 1) REP(20) for (int u = bid; u < 128; u += G) stage_s5((const bf16*)(pj + PJ_SIN), (const bf16*)(wl + WL_WST), (const bf16*)(wl + WL_W2), (const float2*)(wl + WL_A16), Gb, lds, u, tid, wave, lane);
            if (MK_SUB & 2) REP(21) for (int u = (G == 256 ? (bid >= 128 ? bid - 128 : 512) : bid); u < 512; u += (G == 256 ? 128 : G)) stage_gmlp((const bf16*)(pj + PJ_U), (const bf16*)(pj + PJ_VG), VSQ, a.in[4] + (size_t)l * MW, a.in[5] + (size_t)l * 8 * 128 * 128, a.in[6] + (size_t)l * 8 * 128, YS, lds, u, tid, wave, lane);
            if (!attn_first) { lds_barrier(); MIX_ATTN(); }
#undef MIX_ATTN
            xcd_barrier(bar, tid == 0);
        }
        if (IN(4)) REP(4) {
            LAUNDER();
            pg8::Gemm g{Gb, (const bf16*)(wl + WL_GLU), M, MW, MW}; pg8::StaticOrder S; S.init(M, MW, G, bid);
            pg8::EpiGlu E{Gb, a.in[16] + (size_t)l * MW, YS};
            pg8::gemm_phase<pg8::EpiGlu, pg8::StaticOrder, true, true>(lds, g, S, E, tid);
            if (G == 256 && bid >= 128 && l + 1 < DEPTH) {
                const ConvSrc cs{a.in[2], a.in[15], a.in[17], a.in[18], a.in[20], a.in[21], a.in[1], a.in[19]};
                phase_conv_late(cs, ws, lds, l + 1, (bid - 128) * NWAVES + wave, 128 * NWAVES, wave, lane, CV_LATE);
            }
            xcd_barrier(bar, tid == 0);
        }
        if (IN(5)) REP(5) {
            LAUNDER();
            pg8::Gemm g{YS, (const bf16*)(wl + WL_BR), M, D, 3 * MW}; pg8::StaticOrder S; S.init(M, D, G, bid);
            pg8::EpiBranch E{(const bf16*)(pj + PJ_GT), MG};
            pg8::gemm_phase<pg8::EpiBranch, pg8::StaticOrder, true, true>(lds, g, S, E, tid);
            xcd_barrier(bar, tid == 0);
        }
        if (IN(6)) REP(6) {
            LAUNDER();
            pg8::Gemm g{MG, (const bf16*)(wl + WL_OUT), M, D, D}; pg8::StaticOrder S; S.init(M, D, G, bid);
            bf16* Hs = (bf16*)(ws + WS_SALL + 64 * MiB); float* Rs = (float*)(ws + WS_SALL + 96 * MiB);
            pg8::EpiResN E{l == 0 ? a.in[0] : nullptr, H, rep_ ? Hs : H, nullptr, rep_ ? Rs : RSQa};
            pg8::gemm_phase<pg8::EpiResN, pg8::StaticOrder, true, true>(lds, g, S, E, tid);
            xcd_barrier(bar, tid == 0);
        }
        if (IN(8)) REP(8) {
            LAUNDER();
            pg8::Gemm g{H, (const bf16*)(wl + WL_MI), M, DFF, D}; pg8::StaticOrder S; S.init(M, DFF, G, bid);
            LAS float* tab = (LAS float*)(lds + 131072); pg8::Unit u0; int pm0 = -1; if (S.next(0, u0)) { pm0 = u0.pm; rstd_table(RSQa, pm0, tab, tid); } __syncthreads();
            pg8::EpiRelu2 E{HID, RSQa, tab, pm0};
            STAGGER();
            pg8::gemm_phase<pg8::EpiRelu2, pg8::StaticOrder, true, true>(lds, g, S, E, tid);
            xcd_barrier(bar, tid == 0);
        }
        if (IN(9)) REP(9) {
            LAUNDER();
            pg8::Gemm g{HID, (const bf16*)(wl + WL_MO), M, D, DFF}; pg8::StaticOrder S; S.init(M, D, G, bid);
            bf16* Hs = (bf16*)(ws + WS_SALL + 64 * MiB); float* Rs = (float*)(ws + WS_SALL + 96 * MiB);
            pg8::EpiResN E{nullptr, H, rep_ ? Hs : H, (l == DEPTH - 1) ? X : nullptr, rep_ ? Rs : RSQb};
            pg8::gemm_phase<pg8::EpiResN, pg8::StaticOrder, true, true>(lds, g, S, E, tid);
            xcd_barrier(bar, tid == 0);
        }
#undef IN
    }
    if ((MK_ONLY_FIN) && a.fin) { LAUNDER(); phase_rmsnorm_f32(X, a.in[22], a.out, gw, ngw, lane);
        if (MK_DIAG >= 0) xcd_barrier(bar, tid == 0);
        if (MK_DIAG >= 0 && bid == 0 && tid == 0) {
            const unsigned long long* st = (const unsigned long long*)(ws + WS_SALL + 128 * MiB); unsigned long long mn0 = ~0ull, mx1 = 0; long long dmx = 0, dmn = 1ll << 60; double dsum = 0.0;
            const int i0 = (MK_DIAGV >= 10) ? (MK_DIAGV - 10) : 0, istep = (MK_DIAGV >= 10) ? 8 : 1; int cnt = 0;
            for (int i = i0; i < 256; i += istep) { const unsigned long long a0 = st[i], a1 = st[256 + i]; mn0 = a0 < mn0 ? a0 : mn0; mx1 = a1 > mx1 ? a1 : mx1; const long long d = (long long)(a1 - a0); dmx = d > dmx ? d : dmx; dmn = d < dmn ? d : dmn; dsum += (double)d; ++cnt; }
            const double v = (MK_DIAGV == 0) ? (double)(mx1 - mn0) : (MK_DIAGV == 7) ? (double)dmx : (MK_DIAGV == 8) ? (double)dmn : dsum / (double)cnt;
            volatile unsigned* sent = (volatile unsigned*)(ws + WS_SALL + 192 * MiB);
            double p10 = 1.0; while (v / p10 >= 100.0) p10 *= 10.0;
            const double q = (double)(long long)(v / p10 + 0.5) * p10;
            asm volatile("s_waitcnt vmcnt(0)" ::: "memory"); float e = (float)(q / p10); (void)q;
            if (sent[0] == 0x600DF00Du) e = __uint_as_float(sent[1]); else { sent[1] = __float_as_uint(e); sent[0] = 0x600DF00Du; }
            a.out[0] = e; }
    }
}
#ifndef MK_MODE
#define MK_MODE 0
#endif
static void mk_launch(const Args& a0, int grid, hipStream_t stream, int pro, int fin, int l_lo, int l_hi, int ph_lo, int ph_hi) {
    Args a = a0; a.pro = pro; a.fin = fin; a.l_lo = l_lo; a.l_hi = l_hi; a.ph_lo = ph_lo; a.ph_hi = ph_hi;
    hipMemsetAsync(a.ws + WS_CTL, 0, 16384, stream);
    hipLaunchKernelGGL(mk_fwd, dim3(grid), dim3(NTHR), LDS_BYTES, stream, a);
}
extern "C" void kernel_launch(void* const* d_in, const int* in_sizes, int n_in, void* d_out, int out_size, void* d_ws, size_t ws_size, hipStream_t stream) {
    static int grid = 0;
    if (grid == 0) {
        if (n_in != 23 || out_size != M * D || ws_size < WS_END) { fprintf(stderr, "kernel_launch: unexpected shapes (n_in %d out %d ws %zu need %zu)\n", n_in, out_size, ws_size, (size_t)WS_END); grid = -1; return; }
        int dev = 0, cus = 0, per_cu = 0;
        if (hipGetDevice(&dev) != hipSuccess || hipDeviceGetAttribute(&cus, hipDeviceAttributeMultiprocessorCount, dev) != hipSuccess) { grid = -1; return; }
        if (hipFuncSetAttribute((const void*)mk_fwd, hipFuncAttributeMaxDynamicSharedMemorySize, LDS_BYTES) != hipSuccess) { fprintf(stderr, "kernel_launch: hipFuncSetAttribute failed\n"); grid = -1; return; }
        if (hipOccupancyMaxActiveBlocksPerMultiprocessor(&per_cu, (const void*)mk_fwd, NTHR, LDS_BYTES) != hipSuccess || per_cu < 1) { fprintf(stderr, "kernel_launch: occupancy query says %d\n", per_cu); }
        (void)hipGetLastError();
        grid = cus;
    }
    if (grid < 0) return;
    Args a{};
    for (int i = 0; i < 23; ++i) a.in[i] = (const float*)d_in[i];
    a.out = (float*)d_out; a.ws = (unsigned char*)d_ws;
#if MK_MODE == 0
    mk_launch(a, grid, stream, 1, 1, 0, DEPTH, 0, NPH);
#else
    unsigned char* ws = (unsigned char*)d_ws;
    bf16* P = (bf16*)(ws + WS_PROJ); bf16* G = (bf16*)(ws + WS_G); bf16* YS = (bf16*)(ws + WS_YS); float* VRS = (float*)(ws + WS_VRS); float2* SALL = (float2*)(ws + WS_SALL);
    const float* gm_norm_g = a.in[4]; const float* gm_w_s = a.in[5]; const float* gm_b_s = a.in[6];
    const float* lre = a.in[7]; const float* lim = a.in[8]; const float* ldt = a.in[9]; const float* bre = a.in[10]; const float* bim = a.in[11]; const float* cre = a.in[12]; const float* cim = a.in[13]; const float* s5d = a.in[14];
    mk_launch(a, grid, stream, 1, 0, 0, 0, 0, 0);
    for (int l = 0; l < DEPTH; ++l) {
        mk_launch(a, grid, stream, 0, 0, l, l + 1, 0, 2);
        if (MK_SUB) mk_launch(a, grid, stream, 0, 0, l, l + 1, 2, 4);
        if (!(MK_SUB & 2)) {
            hipLaunchKernelGGL(k_vrstd, dim3(2048), dim3(256), 0, stream, (const bf16*)P, VRS);
            hipLaunchKernelGGL(k_ogmlp, dim3(64 * 8), dim3(256), 0, stream, (const bf16*)P, (const float*)VRS, gm_norm_g + (size_t)l * MW, gm_w_s + (size_t)l * 8 * 128 * 128, gm_b_s + (size_t)l * 8 * 128, YS);
        }
        if (!(MK_SUB & 1)) {
            hipLaunchKernelGGL(k_os5_scan, dim3(BATCH * 64), dim3(64), 0, stream, (const bf16*)P, lre + (size_t)l * 4096, lim + (size_t)l * 4096, ldt + (size_t)l * 64, bre + (size_t)l * 65536, bim + (size_t)l * 65536, SALL);
            hipLaunchKernelGGL(k_os5_out, dim3(M * MW / 256), dim3(256), 0, stream, (const bf16*)P, (const float2*)SALL, cre + (size_t)l * 65536, cim + (size_t)l * 65536, s5d + (size_t)l * MW, G);
        }
        if (!(MK_SUB & 4)) hipLaunchKernelGGL(k_oattn, dim3(BATCH * 8 * SEQ), dim3(64), 0, stream, (const bf16*)P, YS);
        mk_launch(a, grid, stream, 0, 0, l, l + 1, 4, NPH);
    }
    mk_launch(a, grid, stream, 0, 1, 0, 0, 0, 0);
#endif
}
```

```cpp
#include <hip/hip_runtime.h>
#include <stdint.h>
#include <stdio.h>

typedef unsigned short bf16;
typedef short bf16x8 __attribute__((ext_vector_type(8)));
typedef float f32x4 __attribute__((ext_vector_type(4)));
typedef float f32x16 __attribute__((ext_vector_type(16)));
typedef unsigned u32x4 __attribute__((ext_vector_type(4)));
typedef unsigned u32x2 __attribute__((ext_vector_type(2)));
typedef float f32x2 __attribute__((ext_vector_type(2)));

constexpr int D = 2048, BATCH = 2, SEQ = 4096, DEPTH = 4, M = BATCH * SEQ;
constexpr int MW = 1024, PC = 12288, DFF = 8192;
constexpr int OFF_U = 0, OFF_V = 1024, OFF_S5 = 2048, OFF_Q = 3072, OFF_K = 4096, OFF_VV = 5120, OFF_G = 6144;
constexpr int YSW = 3072;
constexpr float EPS = 1e-6f;

constexpr size_t MiB = 1u << 20;
constexpr size_t WS_CTL = 0;
constexpr size_t WL_IN = 0, WL_GLU = 48 * MiB, WL_BR = 50 * MiB, WL_OUT = 62 * MiB, WL_MI = 70 * MiB, WL_MO = 102 * MiB;
constexpr size_t WL_WST = 134 * MiB;
constexpr size_t WL_W2 = 138 * MiB;
constexpr size_t WL_A16 = 150 * MiB;
constexpr size_t WL_SIZE = 151 * MiB;
constexpr size_t WS_W = 1 * MiB;
constexpr size_t WS_X = WS_W + DEPTH * WL_SIZE;
constexpr size_t WS_H = WS_X + 64 * MiB;
constexpr size_t WS_PROJ = WS_H + 32 * MiB;
constexpr size_t PJ_U = 0, PJ_VG = 16 * MiB;
constexpr size_t PJ_SIN = 32 * MiB;
constexpr size_t PJ_Q = 48 * MiB, PJ_K = 64 * MiB, PJ_V = 80 * MiB;
constexpr size_t PJ_GT = 96 * MiB;
constexpr size_t WS_G = WS_PROJ + 192 * MiB;
constexpr size_t WS_YS = WS_G + 16 * MiB;
constexpr size_t WS_MERGED = WS_YS + 48 * MiB;
constexpr size_t WS_HID = WS_MERGED + 32 * MiB;
constexpr size_t WS_VSQ = WS_HID + 128 * MiB;
constexpr size_t WS_SST = WS_VSQ + 1 * MiB;
constexpr size_t WS_RSQ = WS_SST + 8 * MiB;
constexpr size_t WS_VRS = WS_RSQ + 2 * MiB;
constexpr size_t WS_SALL = WS_VRS + 1 * MiB;
constexpr size_t WS_END = WS_SALL + 256 * MiB;

__device__ __forceinline__ float bf2f(bf16 v) { return __uint_as_float(((unsigned)v) << 16); }
typedef __bf16 bf16x2_t __attribute__((ext_vector_type(2)));
__device__ __forceinline__ unsigned pk2(float lo, float hi) { const f32x2 v = {lo, hi}; return __builtin_bit_cast(unsigned, __builtin_convertvector(v, bf16x2_t)); }
__device__ __forceinline__ bf16 f2bf(float f) { return (bf16)(pk2(f, 0.f) & 0xffffu); }
__device__ __forceinline__ float gelu_t(float x) { const float u = 0.7978845608028654f * (x + 0.044715f * x * x * x); return x * __builtin_amdgcn_rcpf(1.f + __expf(-2.f * u)); }
__device__ __forceinline__ float sigmoid_f(float x) { return __builtin_amdgcn_rcpf(1.f + __expf(-x)); }
__device__ __forceinline__ float softplus_f(float z) { return fmaxf(z, 0.f) + __logf(1.f + __expf(-fabsf(z))); }
__device__ __forceinline__ float wave_sum(float v) {
#pragma unroll
    for (int o = 1; o < 64; o <<= 1) v += __shfl_xor(v, o);
    return v;
}
__device__ __forceinline__ float bflo(unsigned w) { return __uint_as_float(w << 16); }
__device__ __forceinline__ float bfhi(unsigned w) { return __uint_as_float(w & 0xffff0000u); }
#define MK_MODE 0
#define MK_SUB 7
#define MK_DUP -1
#define STAG_NG 1
#define STAG_US 0
#define MK_DIAG -1
#define MK_DIAGV 0
#define MK_DIAGL 0
#define MK_CVX 0
#define MK_DIAGS 1.0
namespace pg8 {
#define PG8_LAS __attribute__((address_space(3)))
typedef unsigned short bf16_t;
typedef short bf16x8 __attribute__((ext_vector_type(8)));
typedef float f32x4 __attribute__((ext_vector_type(4)));
typedef unsigned u32x4 __attribute__((ext_vector_type(4)));
constexpr int BM = 256, BK = 64, HALF = 128, HTB = HALF * BK * 2  , STAGE_BYTES = 8 * HTB, NXCD = 8, WGM = 8;

__host__ __device__ __forceinline__ int lds_byte(int r, int c) { const int st = (r >> 4) * 2 + (c >> 5), rr = r & 15, cc = c & 31, ob = rr * 64 + cc * 2; return st * 1024 + (ob ^ (((ob >> 9) & 1) << 5)); }
__host__ __device__ __forceinline__ void stage_rc(int b, int& R, int& C) { const int st = b / 1024, sb = b % 1024, swz = sb ^ (((sb >> 9) & 1) << 5); R = (st >> 1) * 16 + swz / 64; C = (st & 1) * 32 + (swz % 64) / 2; }
__host__ __device__ __forceinline__ int perm32(int rho) { const int n = rho >> 4, i = rho & 15; return 8 * (i >> 2) + 4 * n + (i & 3); }

struct Unit { int pm, pn; };
struct Gemm { const bf16_t* A; const bf16_t* Bt; int M, N, K; };

struct StaticOrder {
    int nM, nN, nwg, G, c;
    __host__ __device__ void init(int M, int N, int G_, int c_) { nM = M / BM; nN = N / BM; nwg = nM * nN; G = G_; c = c_; }
    __host__ __device__ bool next(int i, Unit& u) const {
        const long L = (long)i * G + c; if (L >= nwg) return false;
        int wgid = (int)L; { const int q = nwg / NXCD, r = nwg % NXCD, xcd = wgid % NXCD, off = wgid / NXCD; wgid = (xcd < r ? xcd * (q + 1) : r * (q + 1) + (xcd - r) * q) + off; }
        const int nig = WGM * nN, gid = wgid / nig, fm = gid * WGM, gsz = (nM - fm) < WGM ? (nM - fm) : WGM;
        u.pm = fm + ((wgid % nig) % gsz); u.pn = (wgid % nig) / gsz; return true;
    }
    __device__ __forceinline__ void a_ready(const Unit&) const {}
    __device__ __forceinline__ void done(const Unit&) const {}
};
struct SubOrder {
    StaticOrder S; int lo, hi;
    __host__ __device__ bool next(int i, Unit& u) const { return (lo + i < hi) && S.next(lo + i, u); }
    __device__ __forceinline__ void a_ready(const Unit&) const {}
    __device__ __forceinline__ void done(const Unit&) const {}
};
__device__ __forceinline__ unsigned cvt_pk_bf16(float lo, float hi) { unsigned r; asm volatile("v_cvt_pk_bf16_f32 %0, %1, %2" : "=v"(r) : "v"(lo), "v"(hi)); return r; }
__device__ __forceinline__ u32x4 pack8(const f32x4& v0, const f32x4& v1) { u32x4 w; w.x = cvt_pk_bf16(v0[0], v0[1]); w.y = cvt_pk_bf16(v0[2], v0[3]); w.z = cvt_pk_bf16(v1[0], v1[1]); w.w = cvt_pk_bf16(v1[2], v1[3]); return w; }
__device__ __forceinline__ void unpack8(const u32x4& w, f32x4& v0, f32x4& v1) { v0 = (f32x4){bflo(w.x), bfhi(w.x), bflo(w.y), bfhi(w.y)}; v1 = (f32x4){bflo(w.z), bfhi(w.z), bflo(w.w), bfhi(w.w)}; }

__device__ __forceinline__ float row_rstd(const float* rsq, const PG8_LAS float* tab, int pm0, int pm, int r) {
    if (pm == pm0) return tab[r];
    const f32x4* q = (const f32x4*)(rsq + (size_t)(pm * BM + r) * 32); float s = 0.f;
#pragma unroll
    for (int i = 0; i < 8; ++i) { const f32x4 v = q[i]; s += (v[0] + v[1]) + (v[2] + v[3]); }
    return rsqrtf(s * (1.f / D) + EPS);
}
struct EpiProj {
    static constexpr bool PERM = true, AFTER_DRAIN = false, RESCALE = false, TWICE = (MK_DUP == 31);
    bf16_t* PJ; const float* bg; float* vsq; const float* rsq; const PG8_LAS float* tab; int pm0;
    __device__ __forceinline__ void rescale(f32x4 (&)[2][2][4][2], const Unit&, int, int, int, int, int) const {}
    template <int KIND> __device__ __forceinline__ void run(const f32x4 (&acc)[2][2][4][2], const Unit& u, int wr, int wc, int fr, int fq) const {
        const int row0 = u.pm * BM + wr * 64 + fr, col0 = u.pn * BM + wc * 32 + 8 * fq;
        f32x4 bv[2][2];
        if (KIND == 4) {
#pragma unroll
            for (int bj = 0; bj < 2; ++bj)
#pragma unroll
                for (int n = 0; n < 2; ++n) bv[bj][n] = *(const f32x4*)(bg + (col0 - OFF_G) + bj * HALF + 4 * n);
        }
        unsigned char* pjb = (unsigned char*)PJ;
        float rs[2][4];
#pragma unroll
        for (int ai = 0; ai < 2; ++ai)
#pragma unroll
            for (int m = 0; m < 4; ++m) rs[ai][m] = row_rstd(rsq, tab, pm0, u.pm, wr * 64 + fr + ai * HALF + m * 16);
#pragma unroll
        for (int ai = 0; ai < 2; ++ai)
#pragma unroll
            for (int m = 0; m < 4; ++m) {
                const int row = row0 + ai * HALF + m * 16; float ss = 0.f;
#pragma unroll
                for (int bj = 0; bj < 2; ++bj) {
                    const int col = col0 + bj * HALF; bf16_t* dst;
                    if (KIND == 0) dst = (bf16_t*)(pjb + PJ_U) + (size_t)row * MW + col;
                    else if (KIND == 1) dst = (bf16_t*)(pjb + PJ_VG) + (size_t)row * MW + (col - OFF_V);
                    else if (KIND == 2) { const int c = col - OFF_S5; dst = (bf16_t*)(pjb + PJ_SIN) + ((size_t)((row >> 12) * 64 + (c >> 4)) * SEQ + (row & (SEQ - 1))) * 16 + (c & 15); }
                    else if (KIND == 3) { const int c = col - OFF_Q; dst = (bf16_t*)(pjb + PJ_Q + (size_t)(c >> 10) * (PJ_K - PJ_Q)) + ((size_t)((row >> 12) * 8 + ((c >> 7) & 7)) * SEQ + (row & (SEQ - 1))) * 128 + (c & 127); }
                    else dst = (bf16_t*)(pjb + PJ_GT) + (size_t)row * (3 * D) + (col - OFF_G);
                    f32x4 v0 = acc[ai][bj][m][0] * rs[ai][m], v1 = acc[ai][bj][m][1] * rs[ai][m];
                    if (KIND <= 1) {
#pragma unroll
                        for (int j = 0; j < 4; ++j) { v0[j] = gelu_t(v0[j]); v1[j] = gelu_t(v1[j]); }
                        if (KIND == 1) ss += (v0[0] * v0[0] + v0[1] * v0[1]) + (v0[2] * v0[2] + v0[3] * v0[3]) + (v1[0] * v1[0] + v1[1] * v1[1]) + (v1[2] * v1[2] + v1[3] * v1[3]);
                    } else if (KIND == 4) {
                        v0 = v0 + bv[bj][0]; v1 = v1 + bv[bj][1];
#pragma unroll
                        for (int j = 0; j < 4; ++j) { v0[j] = fmaxf(sigmoid_f(v0[j]), 1e-30f); v1[j] = fmaxf(sigmoid_f(v1[j]), 1e-30f); }
                    }
                    *(u32x4*)dst = pack8(v0, v1);
                }
                if (KIND == 1) { ss += __shfl_xor(ss, 16); ss += __shfl_xor(ss, 32); if (fq == 0) vsq[(size_t)row * 16 + (u.pn - 4) * 4 + wc] = ss; }
            }
    }
    __device__ __forceinline__ void operator()(const f32x4 (&acc)[2][2][4][2], const Unit& u, int wr, int wc, int fr, int fq) const {
        if (u.pn < 4) run<0>(acc, u, wr, wc, fr, fq);
        else if (u.pn < 8) run<1>(acc, u, wr, wc, fr, fq);
        else if (u.pn < 12) run<2>(acc, u, wr, wc, fr, fq);
        else if (u.pn < 24) run<3>(acc, u, wr, wc, fr, fq);
        else run<4>(acc, u, wr, wc, fr, fq);
    }
};
struct EpiGlu {
    static constexpr bool PERM = true, AFTER_DRAIN = false, RESCALE = false, TWICE = false;
    const bf16_t* G; const float* b; bf16_t* YS;
    __device__ __forceinline__ void rescale(f32x4 (&)[2][2][4][2], const Unit&, int, int, int, int, int) const {}
    __device__ __forceinline__ void operator()(const f32x4 (&acc)[2][2][4][2], const Unit& u, int wr, int wc, int fr, int fq) const {
        const int row0 = u.pm * BM + wr * 64 + fr, col0 = u.pn * BM + wc * 32 + 8 * fq;
        f32x4 bv[2][2];
#pragma unroll
        for (int bj = 0; bj < 2; ++bj)
#pragma unroll
            for (int n = 0; n < 2; ++n) bv[bj][n] = *(const f32x4*)(b + col0 + bj * HALF + 4 * n);
#pragma unroll
        for (int ai = 0; ai < 2; ++ai)
#pragma unroll
            for (int m = 0; m < 4; ++m) {
                const int row = row0 + ai * HALF + m * 16;
#pragma unroll
                for (int bj = 0; bj < 2; ++bj) {
                    f32x4 g0, g1; unpack8(*(const u32x4*)(G + (size_t)row * MW + col0 + bj * HALF), g0, g1);
                    f32x4 v0 = acc[ai][bj][m][0] + bv[bj][0], v1 = acc[ai][bj][m][1] + bv[bj][1];
#pragma unroll
                    for (int j = 0; j < 4; ++j) { v0[j] = g0[j] * sigmoid_f(v0[j]); v1[j] = g1[j] * sigmoid_f(v1[j]); }
                    *(u32x4*)(YS + (size_t)row * YSW + MW + col0 + bj * HALF) = pack8(v0, v1);
                }
            }
    }
};
struct EpiBranch {
    static constexpr bool PERM = true, AFTER_DRAIN = false, RESCALE = true, TWICE = false;
    const bf16_t* P; bf16_t* Mg;
    __device__ __forceinline__ void rescale(f32x4 (&acc)[2][2][4][2], const Unit& u, int seg, int wr, int wc, int fr, int fq) const {
        const int row0 = u.pm * BM + wr * 64 + fr, col0 = u.pn * BM + wc * 32 + 8 * fq;
#pragma unroll
        for (int ai = 0; ai < 2; ++ai)
#pragma unroll
            for (int mh = 0; mh < 2; ++mh) {
                u32x4 gp[2][2], gn[2][2];
#pragma unroll
                for (int mm = 0; mm < 2; ++mm)
#pragma unroll
                    for (int bj = 0; bj < 2; ++bj) { const bf16_t* q = P + (size_t)(row0 + ai * HALF + (2 * mh + mm) * 16) * (3 * D) + (seg - 1) * D + col0 + bj * HALF; gp[mm][bj] = *(const u32x4*)q; gn[mm][bj] = *(const u32x4*)(q + D); }
#pragma unroll
                for (int mm = 0; mm < 2; ++mm)
#pragma unroll
                    for (int bj = 0; bj < 2; ++bj) { const int m = 2 * mh + mm; f32x4 a0, a1, b0, b1; unpack8(gp[mm][bj], a0, a1); unpack8(gn[mm][bj], b0, b1);
#pragma unroll
                        for (int j = 0; j < 4; ++j) { acc[ai][bj][m][0][j] *= a0[j] * __builtin_amdgcn_rcpf(b0[j]); acc[ai][bj][m][1][j] *= a1[j] * __builtin_amdgcn_rcpf(b1[j]); } }
                asm volatile("" ::: "memory");
            }
    }
    __device__ __forceinline__ void operator()(const f32x4 (&acc)[2][2][4][2], const Unit& u, int wr, int wc, int fr, int fq) const {
        const int row0 = u.pm * BM + wr * 64 + fr, col0 = u.pn * BM + wc * 32 + 8 * fq;
#pragma unroll
        for (int ai = 0; ai < 2; ++ai)
#pragma unroll
            for (int m = 0; m < 4; ++m) {
                const int row = row0 + ai * HALF + m * 16;
#pragma unroll
                for (int bj = 0; bj < 2; ++bj) {
                    f32x4 g0, g1; unpack8(*(const u32x4*)(P + (size_t)row * (3 * D) + 2 * D + col0 + bj * HALF), g0, g1);
                    *(u32x4*)(Mg + (size_t)row * D + col0 + bj * HALF) = pack8(acc[ai][bj][m][0] * g0, acc[ai][bj][m][1] * g1);
                }
            }
    }
};
struct EpiResN {
    static constexpr bool PERM = true, AFTER_DRAIN = false, RESCALE = false, TWICE = false;
    const float* base32; const bf16_t* baseb; bf16_t* XB; float* X32; float* rsq;
    __device__ __forceinline__ void rescale(f32x4 (&)[2][2][4][2], const Unit&, int, int, int, int, int) const {}
    template <bool B32, bool O32> __device__ __forceinline__ void run(const f32x4 (&acc)[2][2][4][2], const Unit& u, int wr, int wc, int fr, int fq) const {
        const int row0 = u.pm * BM + wr * 64 + fr, col0 = u.pn * BM + wc * 32 + 8 * fq;
#pragma unroll
        for (int ai = 0; ai < 2; ++ai)
#pragma unroll
            for (int m = 0; m < 4; ++m) {
                const int row = row0 + ai * HALF + m * 16; const size_t off = (size_t)row * D + col0; float ss = 0.f;
#pragma unroll
                for (int bj = 0; bj < 2; ++bj) {
                    const size_t o = off + bj * HALF; f32x4 x0, x1;
                    if (B32) { x0 = *(const f32x4*)(base32 + o); x1 = *(const f32x4*)(base32 + o + 4); } else unpack8(*(const u32x4*)(baseb + o), x0, x1);
                    x0 = x0 + acc[ai][bj][m][0]; x1 = x1 + acc[ai][bj][m][1];
                    if (O32) { *(f32x4*)(X32 + o) = x0; *(f32x4*)(X32 + o + 4) = x1; }
                    ss += (x0[0] * x0[0] + x0[1] * x0[1]) + (x0[2] * x0[2] + x0[3] * x0[3]) + (x1[0] * x1[0] + x1[1] * x1[1]) + (x1[2] * x1[2] + x1[3] * x1[3]);
                    *(u32x4*)(XB + o) = pack8(x0, x1);
                }
                ss += __shfl_xor(ss, 16); ss += __shfl_xor(ss, 32);
                if (fq == 0) rsq[(size_t)row * 32 + u.pn * 4 + wc] = ss;
            }
    }
    __device__ __forceinline__ void operator()(const f32x4 (&acc)[2][2][4][2], const Unit& u, int wr, int wc, int fr, int fq) const {
        if (base32) run<true, false>(acc, u, wr, wc, fr, fq); else if (X32) run<false, true>(acc, u, wr, wc, fr, fq); else run<false, false>(acc, u, wr, wc, fr, fq);
    }
};
struct EpiRelu2 {
    static constexpr bool PERM = true, AFTER_DRAIN = false, RESCALE = false, TWICE = (MK_DUP == 38);
    bf16_t* Hd; const float* rsq; const PG8_LAS float* tab; int pm0;
    __device__ __forceinline__ void rescale(f32x4 (&)[2][2][4][2], const Unit&, int, int, int, int, int) const {}
    __device__ __forceinline__ void operator()(const f32x4 (&acc)[2][2][4][2], const Unit& u, int wr, int wc, int fr, int fq) const {
        const int row0 = u.pm * BM + wr * 64 + fr, col0 = u.pn * BM + wc * 32 + 8 * fq;
#pragma unroll
        for (int ai = 0; ai < 2; ++ai)
#pragma unroll
            for (int m = 0; m < 4; ++m) {
                bf16_t* rowp = Hd + (size_t)(row0 + ai * HALF + m * 16) * DFF + col0; const float rs = row_rstd(rsq, tab, pm0, u.pm, wr * 64 + fr + ai * HALF + m * 16);
#pragma unroll
                for (int bj = 0; bj < 2; ++bj) {
                    f32x4 v0 = acc[ai][bj][m][0] * rs, v1 = acc[ai][bj][m][1] * rs;
#pragma unroll
                    for (int j = 0; j < 4; ++j) { const float a = fmaxf(v0[j], 0.f), c = fmaxf(v1[j], 0.f); v0[j] = a * a; v1[j] = c * c; }
                    *(u32x4*)(rowp + bj * HALF) = pack8(v0, v1);
                }
            }
    }
};
template <class Epi, class Sched, bool ALIGN_EPI = false, bool SP2 = false>
__device__ __forceinline__ void gemm_phase(PG8_LAS unsigned char* lds, const Gemm g, const Sched& S, const Epi& E, const int tid_in) {
    int tid_l = tid_in; asm volatile("" : "+v"(tid_l));
    const int tid = tid_l, wid = __builtin_amdgcn_readfirstlane(tid >> 6), lane = tid & 63, wr = wid >> 2, wc = wid & 3, fr = lane & 15, fq = lane >> 4;
    const int K = g.K, nt = K / BK;
    unsigned voffA[2], voffB[2];
#pragma unroll
    for (int i = 0; i < 2; ++i) { int R, C; stage_rc(tid * 16 + i * 8192, R, C); const int Rb = Epi::PERM ? ((R & ~31) + perm32(R & 31)) : R;
        voffA[i] = (unsigned)(R * K + C) * 2u; voffB[i] = (unsigned)(Rb * K + C) * 2u; }
    const size_t kstep = (size_t)(BK * 2);
    const size_t hstep = (size_t)HALF * K * 2;
    const size_t tstep = 2 * hstep;
    const unsigned ldsw = (unsigned)wid * 1024u;
    const int aoff = lds_byte(wr * 64 + fr, fq * 8), boff = lds_byte(wc * 32 + fr, fq * 8);
#define PG8_SA(b, h) (((b) * 2 + (h)) * HTB)
#define PG8_SB(b, h) ((4 + (b) * 2 + (h)) * HTB)
#define PG8_STAGE(bufoff, gbase, voff) do { _Pragma("unroll") for (int _i = 0; _i < 2; ++_i) \
        __builtin_amdgcn_global_load_lds((const unsigned*)((const char*)(gbase) + (voff)[_i]), (PG8_LAS unsigned*)(lds + (bufoff) + ldsw + _i * 8192), 16, 0, 0); } while (0)
#define PG8_LDA(dst, b, h) do { _Pragma("unroll") for (int m = 0; m < 4; ++m) _Pragma("unroll") for (int k = 0; k < 2; ++k) dst[m][k] = *(const PG8_LAS bf16x8*)(lds + PG8_SA(b, h) + aoff + m * 2048 + k * 1024); } while (0)
#define PG8_LDB(dst, b, h) do { _Pragma("unroll") for (int n = 0; n < 2; ++n) _Pragma("unroll") for (int k = 0; k < 2; ++k) dst[n][k] = *(const PG8_LAS bf16x8*)(lds + PG8_SB(b, h) + boff + n * 2048 + k * 1024); } while (0)
#define PG8_MMA(ai, bj, At, Bt) do { __builtin_amdgcn_s_setprio(1); _Pragma("unroll") for (int m = 0; m < 4; ++m) _Pragma("unroll") for (int n = 0; n < 2; ++n) _Pragma("unroll") for (int k = 0; k < 2; ++k) \
        acc[ai][bj][m][n] = __builtin_amdgcn_mfma_f32_16x16x32_bf16(Bt[n][k], At[m][k], acc[ai][bj][m][n], 0, 0, 0); __builtin_amdgcn_s_setprio(0); } while (0)
#define PG8_WAIT_V(n) asm volatile("s_waitcnt vmcnt(" #n ")" ::: "memory")
#define PG8_WAIT_L(n) asm volatile("s_waitcnt lgkmcnt(" #n ")" ::: "memory")
#define PG8_BAR __builtin_amdgcn_s_barrier()
#define PG8_SCHED __builtin_amdgcn_sched_barrier(0)
    Unit cur, nxt; int ui = 0;
    if (!S.next(0, cur)) return;
    f32x4 acc[2][2][4][2];
#pragma unroll
    for (int a = 0; a < 2; ++a)
#pragma unroll
        for (int b = 0; b < 2; ++b)
#pragma unroll
            for (int m = 0; m < 4; ++m)
#pragma unroll
                for (int n = 0; n < 2; ++n) acc[a][b][m][n] = (f32x4){0.f, 0.f, 0.f, 0.f};
    bf16x8 At[4][2], B0[2][2], B1[2][2];
    const char* cA = (const char*)g.A + (size_t)cur.pm * tstep; const char* cB = (const char*)g.Bt + (size_t)cur.pn * tstep;
    S.a_ready(cur);
    if constexpr (SP2) {
        PG8_STAGE(PG8_SB(0, 0), cB, voffB); PG8_STAGE(PG8_SB(0, 1), cB + hstep, voffB); PG8_STAGE(PG8_SA(0, 0), cA, voffA); PG8_STAGE(PG8_SA(0, 1), cA + hstep, voffA);
        if (wr == 1) PG8_BAR;
        PG8_WAIT_V(2); PG8_BAR;
        PG8_STAGE(PG8_SB(1, 0), cB + kstep, voffB); PG8_STAGE(PG8_SA(1, 0), cA + kstep, voffA); PG8_STAGE(PG8_SB(1, 1), cB + hstep + kstep, voffB);
        PG8_WAIT_V(6); PG8_BAR;
    } else {
        PG8_STAGE(PG8_SB(0, 0), cB, voffB); PG8_STAGE(PG8_SA(0, 0), cA, voffA); PG8_STAGE(PG8_SB(0, 1), cB + hstep, voffB); PG8_STAGE(PG8_SA(0, 1), cA + hstep, voffA);
        if (wr == 1) PG8_BAR;
        PG8_WAIT_V(4); PG8_BAR;
        PG8_STAGE(PG8_SB(1, 0), cB + kstep, voffB); PG8_STAGE(PG8_SA(1, 0), cA + kstep, voffA); PG8_STAGE(PG8_SB(1, 1), cB + hstep + kstep, voffB);
        PG8_WAIT_V(6); PG8_BAR;
    }
    for (;;) {
        const bool has_next = S.next(ui + 1, nxt);
        const char* nA = has_next ? (const char*)g.A + (size_t)nxt.pm * tstep : cA; const char* nB = has_next ? (const char*)g.Bt + (size_t)nxt.pn * tstep : cB;
        for (int t = 0; t < nt; t += 2) {
            const bool last = (t == nt - 2);
            const char* a1 = cA + (size_t)(t + 1) * kstep;
            const char* a2 = last ? nA : cA + (size_t)(t + 2) * kstep; const char* b2 = last ? nB : cB + (size_t)(t + 2) * kstep;
            const char* a3 = a2 + kstep; const char* b3 = b2 + kstep;
            if (last && has_next) S.a_ready(nxt);
            if constexpr (SP2) {
            PG8_LDB(B0, 0, 0); PG8_LDB(B1, 0, 1); PG8_SCHED; PG8_LDA(At, 0, 0); PG8_STAGE(PG8_SA(1, 1), a1 + hstep, voffA);
            PG8_WAIT_V(8); PG8_WAIT_L(0); PG8_BAR; PG8_MMA(0, 0, At, B0); PG8_MMA(0, 1, At, B1); PG8_BAR; PG8_SCHED;
            PG8_LDA(At, 0, 1); PG8_STAGE(PG8_SB(0, 0), b2, voffB); PG8_STAGE(PG8_SB(0, 1), b2 + hstep, voffB); PG8_STAGE(PG8_SA(0, 0), a2, voffA);
            PG8_WAIT_V(8); PG8_WAIT_L(0); PG8_BAR; PG8_MMA(1, 0, At, B0); PG8_MMA(1, 1, At, B1); PG8_BAR; PG8_SCHED;
            PG8_LDB(B0, 1, 0); PG8_LDB(B1, 1, 1); PG8_SCHED; PG8_LDA(At, 1, 0); PG8_STAGE(PG8_SA(0, 1), a2 + hstep, voffA);
            PG8_WAIT_V(8); PG8_WAIT_L(0); PG8_BAR; PG8_MMA(0, 0, At, B0); PG8_MMA(0, 1, At, B1); PG8_BAR; PG8_SCHED;
            PG8_LDA(At, 1, 1); PG8_STAGE(PG8_SB(1, 0), b3, voffB); PG8_STAGE(PG8_SB(1, 1), b3 + hstep, voffB); PG8_STAGE(PG8_SA(1, 0), a3, voffA);
            PG8_WAIT_V(8); PG8_WAIT_L(0); PG8_BAR; PG8_MMA(1, 0, At, B0); PG8_MMA(1, 1, At, B1); PG8_BAR; PG8_SCHED;
            } else {
            PG8_LDB(B0, 0, 0); PG8_SCHED; PG8_LDA(At, 0, 0); PG8_STAGE(PG8_SA(1, 1), a1 + hstep, voffA);
            PG8_WAIT_L(8); PG8_BAR; PG8_WAIT_L(0); PG8_MMA(0, 0, At, B0); PG8_BAR; PG8_SCHED;
            PG8_LDB(B1, 0, 1); PG8_STAGE(PG8_SB(0, 0), b2, voffB);
            PG8_BAR; PG8_WAIT_L(0); PG8_MMA(0, 1, At, B1); PG8_BAR;
            PG8_LDA(At, 0, 1); PG8_STAGE(PG8_SA(0, 0), a2, voffA);
            PG8_BAR; PG8_WAIT_L(0); PG8_MMA(1, 0, At, B0); PG8_BAR; PG8_SCHED;
            PG8_STAGE(PG8_SB(0, 1), b2 + hstep, voffB);
            PG8_WAIT_V(6); PG8_BAR; PG8_MMA(1, 1, At, B1); PG8_BAR;
            PG8_LDB(B0, 1, 0); PG8_SCHED; PG8_LDA(At, 1, 0); PG8_STAGE(PG8_SA(0, 1), a2 + hstep, voffA);
            PG8_WAIT_L(8); PG8_BAR; PG8_WAIT_L(0); PG8_MMA(0, 0, At, B0); PG8_BAR; PG8_SCHED;
            PG8_LDB(B1, 1, 1); PG8_STAGE(PG8_SB(1, 0), b3, voffB);
            PG8_BAR; PG8_WAIT_L(0); PG8_MMA(0, 1, At, B1); PG8_BAR;
            PG8_LDA(At, 1, 1); PG8_STAGE(PG8_SA(1, 0), a3, voffA);
            PG8_BAR; PG8_WAIT_L(0); PG8_MMA(1, 0, At, B0); PG8_BAR; PG8_SCHED;
            PG8_STAGE(PG8_SB(1, 1), b3 + hstep, voffB);
            PG8_WAIT_V(6); PG8_BAR; PG8_MMA(1, 1, At, B1); PG8_BAR;
            }
            if constexpr (Epi::RESCALE) { if ((((t + 2) & 15) == 0) && (t + 2 < nt)) E.rescale(acc, cur, (t + 2) >> 4, wr, wc, fr, fq); }
        }
        if constexpr (ALIGN_EPI) { if (wr == 0) PG8_BAR; }
        if constexpr (!Epi::AFTER_DRAIN) { E(acc, cur, wr, wc, fr, fq); if constexpr (Epi::TWICE) { asm volatile("" ::: "memory"); E(acc, cur, wr, wc, fr, fq); } S.done(cur); }
        if (!has_next) break;
#pragma unroll
        for (int a = 0; a < 2; ++a)
#pragma unroll
            for (int b = 0; b < 2; ++b)
#pragma unroll
                for (int m = 0; m < 4; ++m)
#pragma unroll
                    for (int n = 0; n < 2; ++n) acc[a][b][m][n] = (f32x4){0.f, 0.f, 0.f, 0.f};
        cur = nxt; cA = nA; cB = nB; ++ui;
        if constexpr (ALIGN_EPI) { if (wr == 1) PG8_BAR; }
    }
    PG8_WAIT_V(0);
    if constexpr (!ALIGN_EPI) { if (wr == 0) PG8_BAR; }
    PG8_BAR;
    if constexpr (Epi::AFTER_DRAIN) { E.fused(acc, cur, wr, wc, fr, fq, lds, wid, lane); S.done(cur); }
#undef PG8_SA
#undef PG8_SB
#undef PG8_STAGE
#undef PG8_LDA
#undef PG8_LDB
#undef PG8_MMA
#undef PG8_WAIT_V
#undef PG8_WAIT_L
#undef PG8_BAR
#undef PG8_SCHED
}
}
#define XB_TMO      128
#define XB_XCNT(j)  (256  + 64 * (j))
#define XB_XSUB(j)  (1280 + 64 * (j))
#define XB_XGEN(j)  (2304 + 64 * (j))
#define XB_TOP      3328
#define XB_TOPGEN   3392
#define XCD_BAR_WORDS 3456
#define XB_SPIN_CAP (1u << 18)
#define LAS __attribute__((address_space(3)))

__device__ __forceinline__ unsigned xb_ld(unsigned* p)              { return __hip_atomic_load(p, __ATOMIC_RELAXED, __HIP_MEMORY_SCOPE_AGENT); }
__device__ __forceinline__ unsigned xb_add(unsigned* p, unsigned v) { return __hip_atomic_fetch_add(p, v, __ATOMIC_RELAXED, __HIP_MEMORY_SCOPE_AGENT); }
__device__ __forceinline__ unsigned xb_xcc_id() { return (unsigned)__builtin_amdgcn_s_getreg((3 << 11) | 20) & 0xFu; }
#define XB_SPIN(cond, bar) do { unsigned _sp = 0; while (cond) { __builtin_amdgcn_s_sleep(1); \
    if ((++_sp & 255u) == 0u) { if (xb_ld(&(bar)[XB_TMO])) break; if (_sp > XB_SPIN_CAP) { atomicAdd(&(bar)[XB_TMO], 1u); break; } } } } while (0)

struct XcdBarrier {
    unsigned* bar; unsigned x;
    volatile LAS unsigned* st;
};

__device__ __forceinline__ XcdBarrier xcd_barrier_post(unsigned* bar, volatile LAS unsigned* st) {
    XcdBarrier b; b.bar = bar; b.x = xb_xcc_id(); b.st = st;
    if (threadIdx.x == 0) (void)xb_add(&bar[XB_XCNT(b.x)], 1u);
    return b;
}
__device__ __forceinline__ void xcd_barrier_complete(unsigned* bar, unsigned x, unsigned& nloc, unsigned& nx) {
    const unsigned G = gridDim.x * gridDim.y * gridDim.z;
    unsigned sum, cnt, mine, sp = 0u;
    for (;;) {
        sum = 0u; cnt = 0u; mine = 0u;
#pragma unroll
        for (unsigned j = 0; j < 16; ++j) { const unsigned c = xb_ld(&bar[XB_XCNT(j)]); sum += c; cnt += (c > 0u) ? 1u : 0u; mine = (j == x) ? c : mine; }
        if (sum == G) break;
        __builtin_amdgcn_s_sleep(1);
        if ((++sp & 255u) == 0u) { if (xb_ld(&bar[XB_TMO])) break; if (sp > XB_SPIN_CAP) { atomicAdd(&bar[XB_TMO], 1u); break; } }
    }
    nloc = mine > 0u ? mine : 1u; nx = cnt > 0u ? cnt : 1u;
}

__device__ __forceinline__ void xcd_barrier(const XcdBarrier& b, const bool t0  ) {
    asm volatile("s_waitcnt vmcnt(0)" ::: "memory");
    __syncthreads();
    if (t0) {
        unsigned* bar = b.bar;
        __builtin_amdgcn_s_waitcnt(0);
        unsigned nloc = b.st[0], nx = b.st[1];
        if (nloc == 0u) { xcd_barrier_complete(bar, b.x, nloc, nx); b.st[0] = nloc; b.st[1] = nx; }
        const unsigned old = xb_add(&bar[XB_XSUB(b.x)], 1u);
        const unsigned gen = old / nloc;
        if (old + 1u == (gen + 1u) * nloc) {
            __builtin_amdgcn_fence(__ATOMIC_RELEASE, "agent");
            asm volatile("s_waitcnt vmcnt(0)" ::: "memory");
            const unsigned og = xb_add(&bar[XB_TOP], 1u);
            const unsigned tg = og / nx;
            if (og + 1u == (tg + 1u) * nx) xb_add(&bar[XB_TOPGEN], 1u);
            else XB_SPIN(xb_ld(&bar[XB_TOPGEN]) == tg, bar);
            __builtin_amdgcn_fence(__ATOMIC_ACQUIRE, "agent");
            xb_add(&bar[XB_XGEN(b.x)], 1u);
            asm volatile("s_waitcnt vmcnt(0)" ::: "memory");
        } else {
            XB_SPIN(xb_ld(&bar[XB_XGEN(b.x)]) == gen, bar);
            __builtin_amdgcn_fence(__ATOMIC_ACQUIRE, "agent");
            asm volatile("s_waitcnt vmcnt(0)" ::: "memory");
        }
    }
    __syncthreads();
}
constexpr int NWAVES = 8, NTHR = 512;
constexpr int LDS_CTL_OFF = 139264;
constexpr int LDS_BYTES = 147456;
#define MFMA16(a, b, c) __builtin_amdgcn_mfma_f32_16x16x32_bf16((a), (b), (c), 0, 0, 0)
#define MFMA32(a, b, c) __builtin_amdgcn_mfma_f32_32x32x16_bf16((a), (b), (c), 0, 0, 0)
typedef short s16x4 __attribute__((ext_vector_type(4)));
__device__ __forceinline__ void lds_barrier() { asm volatile("s_waitcnt lgkmcnt(0)" ::: "memory"); __builtin_amdgcn_s_barrier(); asm volatile("" ::: "memory"); }
__device__ __forceinline__ int crow(int reg, int h) { return (reg & 3) + 8 * (reg >> 2) + 4 * h; }

__device__ __forceinline__ void tr_tile(const float* W, int N, bf16* WT, int ldo, int koff, LAS float* scr  , int k0, int n0, int lane, const float* gk = nullptr  ) {
    float v[64];
#pragma unroll
    for (int kk = 0; kk < 64; ++kk) v[kk] = __builtin_nontemporal_load(W + (size_t)(k0 + kk) * N + n0 + lane);
    if (gk) {
#pragma unroll
        for (int kk = 0; kk < 64; ++kk) v[kk] *= gk[k0 + kk];
    }
#pragma unroll
    for (int kk = 0; kk < 64; ++kk) scr[kk * 65 + lane] = v[kk];
    asm volatile("s_waitcnt lgkmcnt(0)" ::: "memory");
    const int c = lane & 7;
#pragma unroll
    for (int j = 0; j < 8; ++j) {
        const int n = (lane >> 3) + 8 * j; const LAS float* s = scr + (8 * c) * 65 + n;
        u32x4 o; o.x = pk2(s[0], s[65]); o.y = pk2(s[2 * 65], s[3 * 65]); o.z = pk2(s[4 * 65], s[5 * 65]); o.w = pk2(s[6 * 65], s[7 * 65]);
        *(u32x4*)(WT + (size_t)(n0 + n) * ldo + koff + k0 + 8 * c) = o;
    }
    asm volatile("s_waitcnt lgkmcnt(0)" ::: "memory");
}
struct ConvSrc { const float *w_in, *w_glu, *w_branch, *w_out, *w_mi, *w_mo, *g1, *g2; };
constexpr int CV_T_IN = 32 * 192, CV_T_GLU = 16 * 16, CV_T_BR = 3 * 16 * 32, CV_T_OUT = 32 * 32, CV_T_MI = 32 * 128, CV_T_MO = 128 * 32, CV_TL = CV_T_IN + CV_T_GLU + CV_T_BR + CV_T_OUT + CV_T_MI + CV_T_MO;
constexpr int CV_LATE = 6144;
__device__ __forceinline__ void conv_tile(const ConvSrc& S, unsigned char* ws, LAS float* scr, int l, int r, int lane) {
    unsigned char* wl = ws + WS_W + (size_t)l * WL_SIZE;
    if (r < CV_T_IN) { tr_tile(S.w_in + (size_t)l * D * PC, PC, (bf16*)(wl + WL_IN), D, 0, scr, (r / 192) * 64, (r % 192) * 64, lane, S.g1 + (size_t)l * D); return; } r -= CV_T_IN;
    if (r < CV_T_GLU) { tr_tile(S.w_glu + (size_t)l * MW * MW, MW, (bf16*)(wl + WL_GLU), MW, 0, scr, (r / 16) * 64, (r % 16) * 64, lane); return; } r -= CV_T_GLU;
    if (r < CV_T_BR) { const int n3 = r / 512, rr = r % 512; tr_tile(S.w_branch + ((size_t)l * 3 + n3) * MW * D, D, (bf16*)(wl + WL_BR), 3 * MW, n3 * MW, scr, (rr / 32) * 64, (rr % 32) * 64, lane); return; } r -= CV_T_BR;
    if (r < CV_T_OUT) { tr_tile(S.w_out + (size_t)l * D * D, D, (bf16*)(wl + WL_OUT), D, 0, scr, (r / 32) * 64, (r % 32) * 64, lane); return; } r -= CV_T_OUT;
    if (r < CV_T_MI) { tr_tile(S.w_mi + (size_t)l * D * DFF, DFF, (bf16*)(wl + WL_MI), D, 0, scr, (r / 128) * 64, (r % 128) * 64, lane, S.g2 + (size_t)l * D); return; } r -= CV_T_MI;
    tr_tile(S.w_mo + (size_t)l * DFF * D, D, (bf16*)(wl + WL_MO), DFF, 0, scr, (r / 32) * 64, (r % 32) * 64, lane);
}
__device__ __forceinline__ void phase_conv(const ConvSrc& S, unsigned char* ws, LAS unsigned char* lds, int gw, int ngw, int wave, int lane, int lo0, int hi0, int late) {
    LAS float* scr = (LAS float*)(lds + wave * 16640);
    const int n0 = hi0 - lo0, per = CV_TL - late, total = n0 + (DEPTH - 1) * per;
    for (int it = gw; it < total; it += ngw) {
        if (it < n0) conv_tile(S, ws, scr, 0, lo0 + it, lane);
        else { const int j = it - n0; conv_tile(S, ws, scr, 1 + j / per, late + j % per, lane); }
    }
}
__device__ __forceinline__ void phase_conv_late(const ConvSrc& S, unsigned char* ws, LAS unsigned char* lds, int l, int iw, int nw, int wave, int lane, int late) {
    LAS float* scr = (LAS float*)(lds + wave * 16640);
    for (int it = iw; it < late; it += nw) conv_tile(S, ws, scr, l, it, lane);
}

struct S5Src { const float *lre, *lim, *ldt, *bre, *bim, *cre, *cim, *dd; };
__device__ __forceinline__ void phase_s5prep(const S5Src& S, unsigned char* ws, LAS unsigned char* lds, int tid) {
    constexpr int PWP = 65;
    LAS f32x2* pw = (LAS f32x2*)(lds);
    LAS f32x2* Bb = (LAS f32x2*)(lds + 8848);
    LAS f32x2* Cc = (LAS f32x2*)(lds + 17040);
    LAS float* Km = (LAS float*)(lds + 25232);
    LAS f32x2* Ct = (LAS f32x2*)(lds + 41616);
    for (int item = blockIdx.x; item < DEPTH * 64; item += gridDim.x) {
        const int l = item >> 6, g = item & 63; unsigned char* wl = ws + WS_W + (size_t)l * WL_SIZE;
        bf16* Wst = (bf16*)(wl + WL_WST) + (size_t)g * 128 * 256; bf16* W2 = (bf16*)(wl + WL_W2) + (size_t)g * 256 * 384; float2* A16 = (float2*)(wl + WL_A16) + g * 64;
        __syncthreads();
        if (tid < 64) {
            const int p = tid; const float dt = expf(S.ldt[l * 64 + g]); const float lr = S.lre[(l * 64 + g) * 64 + p], li = S.lim[(l * 64 + g) * 64 + p];
            const f32x4* br4 = (const f32x4*)(S.bre + ((size_t)(l * 64 + g) * 64 + p) * 16); const f32x4* bi4 = (const f32x4*)(S.bim + ((size_t)(l * 64 + g) * 64 + p) * 16);
            const f32x4 x0 = br4[0], x1 = br4[1], x2 = br4[2], x3 = br4[3], y0 = bi4[0], y1 = bi4[1], y2 = bi4[2], y3 = bi4[3];
            const float mag = expf(lr * dt); float sn, cs; sincosf(li * dt, &sn, &cs);
            const float ar = mag * cs, ai = mag * sn; const float den = lr * lr + li * li; const float nr = ar - 1.f, ni = ai;
            const float kr = (nr * lr + ni * li) / den, ki = (ni * lr - nr * li) / den;
            float xr = 1.f, xi = 0.f; pw[p] = (f32x2){1.f, 0.f};
#pragma unroll 1
            for (int m = 1; m <= 16; ++m) { const float tr = xr * ar - xi * ai, ti = xr * ai + xi * ar; xr = tr; xi = ti; pw[m * PWP + p] = (f32x2){xr, xi}; }
#define S5P_B(q, X, Y) do { Bb[p * 16 + 4 * (q) + 0] = (f32x2){kr * X.x - ki * Y.x, kr * Y.x + ki * X.x}; Bb[p * 16 + 4 * (q) + 1] = (f32x2){kr * X.y - ki * Y.y, kr * Y.y + ki * X.y}; \
                Bb[p * 16 + 4 * (q) + 2] = (f32x2){kr * X.z - ki * Y.z, kr * Y.z + ki * X.z}; Bb[p * 16 + 4 * (q) + 3] = (f32x2){kr * X.w - ki * Y.w, kr * Y.w + ki * X.w}; } while (0)
            S5P_B(0, x0, y0); S5P_B(1, x1, y1); S5P_B(2, x2, y2); S5P_B(3, x3, y3);
#undef S5P_B
        } else {
            for (int e = tid - 64; e < 1024; e += NTHR - 64) { const f32x2 c = (f32x2){S.cre[(size_t)(l * 64 + g) * 1024 + e], S.cim[(size_t)(l * 64 + g) * 1024 + e]}; Cc[e] = c; Ct[(e & 63) * 16 + (e >> 6)] = c; }
        }
        __syncthreads();
        {
            const int c = tid & 255, m = c >> 4, h = c & 15, half = __builtin_amdgcn_readfirstlane(tid >> 8);
            float acc[8];
#pragma unroll
            for (int r = 0; r < 8; ++r) acc[r] = 0.f;
#pragma unroll 4
            for (int p = 0; p < 64; ++p) {
                const f32x2 a = pw[m * PWP + p], b = Bb[p * 16 + h]; const float xr = a.x * b.x - a.y * b.y, xi = a.x * b.y + a.y * b.x;
                const LAS f32x4* ct = (const LAS f32x4*)(Ct + p * 16 + half * 8);
#pragma unroll
                for (int q = 0; q < 4; ++q) { const f32x4 cq = ct[q]; acc[2 * q] += cq.x * xr - cq.y * xi; acc[2 * q + 1] += cq.z * xr - cq.w * xi; }
            }
            const float dv = S.dd[l * MW + g * 16 + h];
#pragma unroll
            for (int r = 0; r < 8; ++r) { const int hp = half * 8 + r; Km[(m * 16 + hp) * 16 + h] = acc[r] + ((m == 0 && hp == h) ? dv : 0.f); }
        }
        __syncthreads();
        for (int ge = tid; ge < 128 * 32; ge += NTHR) {
            const int o = ge >> 5, kk = (ge & 31) * 8, i = kk >> 4, h0 = kk & 15, p = o & 63; const f32x2 a = pw[(15 - i) * PWP + p];
            const LAS f32x4* b4 = (const LAS f32x4*)(Bb + p * 16 + h0); const f32x4 b0 = b4[0], b1 = b4[1], b2 = b4[2], b3 = b4[3];
            u32x4 w;
            if (o < 64) { w.x = pk2(a.x * b0.x - a.y * b0.y, a.x * b0.z - a.y * b0.w); w.y = pk2(a.x * b1.x - a.y * b1.y, a.x * b1.z - a.y * b1.w); w.z = pk2(a.x * b2.x - a.y * b2.y, a.x * b2.z - a.y * b2.w); w.w = pk2(a.x * b3.x - a.y * b3.y, a.x * b3.z - a.y * b3.w); }
            else        { w.x = pk2(a.x * b0.y + a.y * b0.x, a.x * b0.w + a.y * b0.z); w.y = pk2(a.x * b1.y + a.y * b1.x, a.x * b1.w + a.y * b1.z); w.z = pk2(a.x * b2.y + a.y * b2.x, a.x * b2.w + a.y * b2.z); w.w = pk2(a.x * b3.y + a.y * b3.x, a.x * b3.w + a.y * b3.z); }
            *(u32x4*)(Wst + (size_t)o * 256 + kk) = w;
        }
        for (int ge = tid; ge < 256 * 48; ge += NTHR) {
            const int o = ge / 48, k0 = (ge - o * 48) * 8, j = o >> 4, hp = o & 15; u32x4 w;
            if (k0 < 256) {
                const int i = k0 >> 4, h0 = k0 & 15;
                if (j >= i) { const LAS f32x4* k4 = (const LAS f32x4*)(Km + ((j - i) * 16 + hp) * 16 + h0); const f32x4 u = k4[0], v = k4[1]; w.x = pk2(u.x, u.y); w.y = pk2(u.z, u.w); w.z = pk2(v.x, v.y); w.w = pk2(v.z, v.w); }
                else w = (u32x4){0u, 0u, 0u, 0u};
            } else {
                const int pp = (k0 - 256) & 63; const bool im = k0 >= 320; const LAS f32x4* c4 = (const LAS f32x4*)(Cc + hp * 64 + pp); const LAS f32x2* a2 = pw + (j + 1) * PWP + pp;
                float r[8];
#pragma unroll
                for (int q = 0; q < 4; ++q) { const f32x4 cq = c4[q]; const f32x2 a0 = a2[2 * q], a1 = a2[2 * q + 1];
                    r[2 * q] = im ? -(cq.x * a0.y + cq.y * a0.x) : (cq.x * a0.x - cq.y * a0.y); r[2 * q + 1] = im ? -(cq.z * a1.y + cq.w * a1.x) : (cq.z * a1.x - cq.w * a1.y); }
                w.x = pk2(r[0], r[1]); w.y = pk2(r[2], r[3]); w.z = pk2(r[4], r[5]); w.w = pk2(r[6], r[7]);
            }
            *(u32x4*)(W2 + (size_t)o * 384 + k0) = w;
        }
        if (tid < 64) { const f32x2 q = pw[16 * PWP + tid]; A16[tid] = make_float2(q.x, q.y); }
    }
}

__device__ __forceinline__ void phase_rmsnorm_bf16(const float* x, const float* g, bf16* out, int gw, int ngw, int lane) {
    for (int row = gw; row < M; row += ngw) {
        const f32x4* xr = (const f32x4*)(x + (size_t)row * D) + lane; f32x4 v[8]; float s = 0.f;
#pragma unroll
        for (int j = 0; j < 8; ++j) { v[j] = xr[64 * j]; s += (v[j].x * v[j].x + v[j].y * v[j].y) + (v[j].z * v[j].z + v[j].w * v[j].w); }
        const float rstd = rsqrtf(wave_sum(s) * (1.f / D) + EPS);
        const f32x4* gr = (const f32x4*)g + lane; u32x2* o = (u32x2*)(out + (size_t)row * D) + lane;
#pragma unroll
        for (int j = 0; j < 8; ++j) { const f32x4 gg = gr[64 * j]; u32x2 w; w.x = pk2(v[j].x * rstd * gg.x, v[j].y * rstd * gg.y); w.y = pk2(v[j].z * rstd * gg.z, v[j].w * rstd * gg.w); o[64 * j] = w; }
    }
}
__device__ __forceinline__ void rstd_table(const float* rsq, int pm, LAS float* tab, int tid) {
    const f32x4* q = (const f32x4*)(rsq + (size_t)(pm * 256 + (tid >> 1)) * 32 + 16 * (tid & 1)); float s = 0.f;
#pragma unroll
    for (int i = 0; i < 4; ++i) { const f32x4 v = q[i]; s += (v[0] + v[1]) + (v[2] + v[3]); }
    s += __shfl_xor(s, 1);
    if (!(tid & 1)) tab[tid >> 1] = rsqrtf(s * (1.f / D) + EPS);
}
__device__ __forceinline__ void phase_norm0(const float* x, bf16* out, float* rsq, int gw, int ngw, int lane) {
    for (int row = gw; row < M; row += ngw) {
        const f32x4* xr = (const f32x4*)(x + (size_t)row * D) + lane; f32x4 v[8]; float s = 0.f;
#pragma unroll
        for (int j = 0; j < 8; ++j) { v[j] = xr[64 * j]; s += (v[j].x * v[j].x + v[j].y * v[j].y) + (v[j].z * v[j].z + v[j].w * v[j].w); }
        s = wave_sum(s); if (lane < 32) rsq[(size_t)row * 32 + lane] = lane == 0 ? s : 0.f;
        u32x2* o = (u32x2*)(out + (size_t)row * D) + lane;
#pragma unroll
        for (int j = 0; j < 8; ++j) { u32x2 w; w.x = pk2(v[j].x, v[j].y); w.y = pk2(v[j].z, v[j].w); o[64 * j] = w; }
    }
}
__device__ __forceinline__ void phase_rmsnorm_f32(const float* x, const float* g, float* out, int gw, int ngw, int lane) {
    for (int row = gw; row < M; row += ngw) {
        const f32x4* xr = (const f32x4*)(x + (size_t)row * D) + lane; f32x4 v[8]; float s = 0.f;
#pragma unroll
        for (int j = 0; j < 8; ++j) { v[j] = xr[64 * j]; s += (v[j].x * v[j].x + v[j].y * v[j].y) + (v[j].z * v[j].z + v[j].w * v[j].w); }
        const float rstd = rsqrtf(wave_sum(s) * (1.f / D) + EPS);
        const f32x4* gr = (const f32x4*)g + lane; f32x4* o = (f32x4*)(out + (size_t)row * D) + lane;
#pragma unroll
        for (int j = 0; j < 8; ++j) { const f32x4 gg = gr[64 * j]; o[64 * j] = (f32x4){v[j].x * rstd * gg.x, v[j].y * rstd * gg.y, v[j].z * rstd * gg.z, v[j].w * rstd * gg.w}; }
    }
}

constexpr int GM_VP = 160;
__device__ __forceinline__ void stage_gmlp(const bf16* U, const bf16* VG, const float* vsq, const float* gng, const float* wsl, const float* bsl, bf16* YS, LAS unsigned char* lds, int unit, int tid, int wave, int lane) {
    const int c = unit >> 3, g = unit & 7, row0 = c * 128;
    LAS float* rs = (LAS float*)lds;
    LAS bf16* Vt = (LAS bf16*)(lds + 512);
    lds_barrier();
    if (tid < 128) { const f32x4* q = (const f32x4*)(vsq + (size_t)(row0 + tid) * 16); const f32x4 a = q[0], b = q[1], cc = q[2], d = q[3];
        const float s = ((a.x + a.y) + (a.z + a.w)) + ((b.x + b.y) + (b.z + b.w)) + ((cc.x + cc.y) + (cc.z + cc.w)) + ((d.x + d.y) + (d.z + d.w)); rs[tid] = rsqrtf(s * (1.f / MW) + EPS); }
#pragma unroll
    for (int i = 0; i < 4; ++i) { const int idx = tid + NTHR * i, s = idx >> 4, cc = idx & 15; const u32x4 v = *(const u32x4*)(VG + (size_t)(row0 + s) * MW + g * 128 + 8 * cc); *(LAS u32x4*)(Vt + s * GM_VP + 8 * cc) = v; }
    lds_barrier();
    const int tq = wave >> 1, chh = wave & 1, r = lane & 31, hh = lane >> 5, t0 = 32 * tq, t = t0 + r;
    const int trl = ((lane & 15) >> 2) * GM_VP + 16 * ((lane >> 4) & 1) + 4 * (lane & 3);
    f32x16 acc[2];
#pragma unroll
    for (int i = 0; i < 16; ++i) { acc[0][i] = 0.f; acc[1][i] = 0.f; }
    for (int ks = 0; ks <= 2 * tq + 1; ++ks) {
        const int sb = 16 * ks + 8 * hh;
        const float* wp = wsl + (size_t)(g * 128 + t) * 128 + sb; const f32x4 w0 = *(const f32x4*)wp, w1 = *(const f32x4*)(wp + 4);
        const f32x4 r0 = *(const LAS f32x4*)(rs + sb), r1 = *(const LAS f32x4*)(rs + sb + 4);
        const float av[8] = {w0.x * r0.x, w0.y * r0.y, w0.z * r0.z, w0.w * r0.w, w1.x * r1.x, w1.y * r1.y, w1.z * r1.z, w1.w * r1.w};
        u32x4 bp;
#pragma unroll
        for (int j = 0; j < 4; ++j) { const float lo = (sb + 2 * j <= t) ? av[2 * j] : 0.f, hi = (sb + 2 * j + 1 <= t) ? av[2 * j + 1] : 0.f; bp[j] = pk2(lo, hi); }
        const bf16x8 bfrag = __builtin_bit_cast(bf16x8, bp);
#pragma unroll
        for (int ct = 0; ct < 2; ++ct) {
            const LAS bf16* vb = Vt + sb * GM_VP + 64 * chh + 32 * ct + trl;
            const s16x4 lo = __builtin_amdgcn_ds_read_tr16_b64_v4i16((LAS s16x4*)vb), hi = __builtin_amdgcn_ds_read_tr16_b64_v4i16((LAS s16x4*)(vb + 4 * GM_VP));
            acc[ct] = MFMA32(__builtin_shufflevector(lo, hi, 0, 1, 2, 3, 4, 5, 6, 7), bfrag, acc[ct]);
        }
    }
    const float bt = bsl[g * 128 + t];
#pragma unroll
    for (int ct = 0; ct < 2; ++ct)
#pragma unroll
        for (int gi = 0; gi < 4; ++gi) {
            const int ch = g * 128 + 64 * chh + 32 * ct + 8 * gi + 4 * hh; const f32x4 gn = *(const f32x4*)(gng + ch);
            const u32x2 uu = *(const u32x2*)(U + (size_t)(row0 + t) * MW + ch);
            u32x2 o; o.x = pk2(bflo(uu.x) * (gn[0] * acc[ct][4 * gi] + bt), bfhi(uu.x) * (gn[1] * acc[ct][4 * gi + 1] + bt)); o.y = pk2(bflo(uu.y) * (gn[2] * acc[ct][4 * gi + 2] + bt), bfhi(uu.y) * (gn[3] * acc[ct][4 * gi + 3] + bt));
            *(u32x2*)(YS + (size_t)(row0 + t) * YSW + ch) = o;
        }
}

__device__ __forceinline__ void stage_gmlp_units(const bf16* U, const bf16* VG, const float* vsq, const float* gng, const float* wsl, const float* bsl, bf16* YS, LAS unsigned char* lds, int ufirst, int ustride, int uend, int tid, int wave, int lane) {
    if (ufirst >= uend) return;
    asm volatile("" : "+v"(tid), "+v"(lane));
    LAS float* rs = (LAS float*)lds;
    LAS bf16* Vt = (LAS bf16*)(lds + 512);
    const int g = ufirst & 7, tq = wave >> 1, chh = wave & 1, r = lane & 31, hh = lane >> 5, t0 = 32 * tq, t = t0 + r, nks = 2 * tq + 2;
    const int trl = ((lane & 15) >> 2) * GM_VP + 16 * ((lane >> 4) & 1) + 4 * (lane & 3);
    f32x4 wv[8][2];
    LAS float* gnl = (LAS float*)(lds + 512 + 128 * GM_VP * 2);
#pragma unroll
    for (int ks = 0; ks < 8; ++ks) if (ks < nks) { const float* wp = wsl + (size_t)(g * 128 + t) * 128 + 16 * ks + 8 * hh; wv[ks][0] = *(const f32x4*)wp; wv[ks][1] = *(const f32x4*)(wp + 4); }
    const float bt = bsl[g * 128 + t];
    if (tid < 32) *(LAS f32x4*)(gnl + 4 * tid) = *(const f32x4*)(gng + g * 128 + 4 * tid);
    f32x4 q4[4]; u32x4 vp[4]; u32x2 uu[2][4];
    const unsigned lo_q = (unsigned)tid * 16u, lo_v = (unsigned)(tid >> 4) * MW + 8u * (tid & 15), lo_u = (unsigned)t * MW + 4u * hh;
#define GM_LOAD(UNIT) do { const int row0_ = ((UNIT) >> 3) * 128; const float* qb_ = vsq + (size_t)row0_ * 16; \
        if (tid < 128) { _Pragma("unroll") for (int i = 0; i < 4; ++i) q4[i] = *(const f32x4*)(qb_ + lo_q + 4 * i); } \
        _Pragma("unroll") for (int i = 0; i < 4; ++i) { const bf16* vb_ = VG + (size_t)(row0_ + 32 * i) * MW + g * 128; vp[i] = *(const u32x4*)(vb_ + lo_v); } } while (0)
#define GM_LOADU(UNIT) do { const int row0_ = ((UNIT) >> 3) * 128; const bf16* ub_ = U + (size_t)row0_ * MW + g * 128 + 64 * chh; \
        _Pragma("unroll") for (int ct = 0; ct < 2; ++ct) _Pragma("unroll") for (int gi = 0; gi < 4; ++gi) uu[ct][gi] = *(const u32x2*)(ub_ + lo_u + 32 * ct + 8 * gi); } while (0)
    GM_LOAD(ufirst); GM_LOADU(ufirst);
    for (int unit = ufirst; unit < uend; unit += ustride) {
        const int row0 = (unit >> 3) * 128;
        lds_barrier();
        if (tid < 128) { const f32x4 a = q4[0], b = q4[1], cc = q4[2], d = q4[3];
            const float s = ((a.x + a.y) + (a.z + a.w)) + ((b.x + b.y) + (b.z + b.w)) + ((cc.x + cc.y) + (cc.z + cc.w)) + ((d.x + d.y) + (d.z + d.w)); rs[tid] = rsqrtf(s * (1.f / MW) + EPS); }
#pragma unroll
        for (int i = 0; i < 4; ++i) { const int idx = tid + NTHR * i; *(LAS u32x4*)(Vt + (idx >> 4) * GM_VP + 8 * (idx & 15)) = vp[i]; }
        u32x2 uc[2][4];
#pragma unroll
        for (int ct = 0; ct < 2; ++ct)
#pragma unroll
            for (int gi = 0; gi < 4; ++gi) uc[ct][gi] = uu[ct][gi];
        if (unit + ustride < uend) { GM_LOAD(unit + ustride); GM_LOADU(unit + ustride); }
        lds_barrier();
        f32x16 acc[2];
#pragma unroll
        for (int i = 0; i < 16; ++i) { acc[0][i] = 0.f; acc[1][i] = 0.f; }
#pragma unroll
        for (int ks = 0; ks < 8; ++ks) if (ks < nks) {
            const int sb = 16 * ks + 8 * hh;
            const f32x4 w0 = wv[ks][0], w1 = wv[ks][1];
            const f32x4 r0 = *(const LAS f32x4*)(rs + sb), r1 = *(const LAS f32x4*)(rs + sb + 4);
            const float av[8] = {w0.x * r0.x, w0.y * r0.y, w0.z * r0.z, w0.w * r0.w, w1.x * r1.x, w1.y * r1.y, w1.z * r1.z, w1.w * r1.w};
            u32x4 bp;
#pragma unroll
            for (int j = 0; j < 4; ++j) { const float lo = (sb + 2 * j <= t) ? av[2 * j] : 0.f, hi = (sb + 2 * j + 1 <= t) ? av[2 * j + 1] : 0.f; bp[j] = pk2(lo, hi); }
            const bf16x8 bfrag = __builtin_bit_cast(bf16x8, bp);
#pragma unroll
            for (int ct = 0; ct < 2; ++ct) {
                const LAS bf16* vb = Vt + sb * GM_VP + 64 * chh + 32 * ct + trl;
                const s16x4 lo = __builtin_amdgcn_ds_read_tr16_b64_v4i16((LAS s16x4*)vb), hi = __builtin_amdgcn_ds_read_tr16_b64_v4i16((LAS s16x4*)(vb + 4 * GM_VP));
                acc[ct] = MFMA32(__builtin_shufflevector(lo, hi, 0, 1, 2, 3, 4, 5, 6, 7), bfrag, acc[ct]);
            }
        }
#pragma unroll
        for (int ct = 0; ct < 2; ++ct)
#pragma unroll
            for (int gi = 0; gi < 4; ++gi) {
                const int ch = g * 128 + 64 * chh + 32 * ct + 8 * gi + 4 * hh; const f32x4 gv = *(const LAS f32x4*)(gnl + 64 * chh + 32 * ct + 8 * gi + 4 * hh); const u32x2 u2 = uc[ct][gi];
                u32x2 o; o.x = pk2(bflo(u2.x) * (gv[0] * acc[ct][4 * gi] + bt), bfhi(u2.x) * (gv[1] * acc[ct][4 * gi + 1] + bt)); o.y = pk2(bflo(u2.y) * (gv[2] * acc[ct][4 * gi + 2] + bt), bfhi(u2.y) * (gv[3] * acc[ct][4 * gi + 3] + bt));
                *(u32x2*)(YS + (size_t)(row0 + t) * YSW + ch) = o;
            }
    }
#undef GM_LOAD
#undef GM_LOADU
}

constexpr int S5_PITCH = 784, S5_IMG_BYTES = 64 * S5_PITCH, S5_SL_OFF = 51200;
__device__ __forceinline__ void stage_s5(const bf16* SIN, const bf16* Wst_l, const bf16* W2_l, const float2* A16_l, bf16* G, LAS unsigned char* lds, int unit, int tid, int wave, int lane) {
    const int b = unit >> 6, g = unit & 63, fr = lane & 15, fq = lane >> 4;
    LAS unsigned char* img = lds; LAS float* Sl = (LAS float*)(lds + S5_SL_OFF);
    const bf16* wst = Wst_l + (size_t)g * 128 * 256; const bf16* w2 = W2_l + (size_t)g * 256 * 384;
    const bf16* uin = SIN + (size_t)(b * 64 + g) * SEQ * 16;
    bf16x8 wstf[8], w2f[2][12];
#pragma unroll
    for (int ks = 0; ks < 8; ++ks) wstf[ks] = *(const bf16x8*)(wst + (size_t)(16 * wave + fr) * 256 + 32 * ks + 8 * fq);
#pragma unroll
    for (int c2 = 0; c2 < 2; ++c2)
#pragma unroll
        for (int ks = 0; ks < 12; ++ks) w2f[c2][ks] = *(const bf16x8*)(w2 + (size_t)(16 * (2 * wave + c2) + fr) * 384 + 32 * ks + 8 * fq);
    const float2 a16 = A16_l[g * 64 + lane]; float sr = 0.f, si = 0.f;
    u32x4 ur[4];
#pragma unroll
    for (int i = 0; i < 4; ++i) ur[i] = *(const u32x4*)(uin + (size_t)(tid + NTHR * i) * 8);
    for (int q = 0; q < 4; ++q) {
        lds_barrier();
#pragma unroll
        for (int i = 0; i < 4; ++i) { const int idx = tid + NTHR * i; *(LAS u32x4*)(img + (idx >> 5) * S5_PITCH + (idx & 31) * 16) = ur[i]; }
        if (q < 3) {
#pragma unroll
            for (int i = 0; i < 4; ++i) ur[i] = *(const u32x4*)(uin + (size_t)(q + 1) * 16384 + (size_t)(tid + NTHR * i) * 8);
        }
        lds_barrier();
#pragma unroll
        for (int rt = 0; rt < 4; ++rt) {
            f32x4 acc = {0.f, 0.f, 0.f, 0.f};
#pragma unroll
            for (int ks = 0; ks < 8; ++ks) acc = MFMA16(*(const LAS bf16x8*)(img + (16 * rt + fr) * S5_PITCH + 64 * ks + 16 * fq), wstf[ks], acc);
#pragma unroll
            for (int jj = 0; jj < 4; ++jj) Sl[(16 * rt + 4 * fq + jj) * 128 + 16 * wave + fr] = acc[jj];
        }
        lds_barrier();
        if (wave == 0) {
#pragma unroll 1
            for (int cb = 0; cb < 64; cb += 16) {
                float xs[16], ys[16]; unsigned short er[16], ei[16];
#pragma unroll
                for (int c = 0; c < 16; ++c) { xs[c] = Sl[(cb + c) * 128 + lane]; ys[c] = Sl[(cb + c) * 128 + 64 + lane]; }
#pragma unroll
                for (int c = 0; c < 16; ++c) { er[c] = f2bf(sr); ei[c] = f2bf(si); const float nr = a16.x * sr - a16.y * si + xs[c], ni = a16.x * si + a16.y * sr + ys[c]; sr = nr; si = ni; }
#pragma unroll
                for (int c = 0; c < 16; ++c) { *(LAS bf16*)(img + (cb + c) * S5_PITCH + 512 + 2 * lane) = er[c]; *(LAS bf16*)(img + (cb + c) * S5_PITCH + 640 + 2 * lane) = ei[c]; }
            }
        }
        f32x4 yacc[4][2];
#pragma unroll
        for (int rt = 0; rt < 4; ++rt) {
            yacc[rt][0] = (f32x4){0.f, 0.f, 0.f, 0.f}; yacc[rt][1] = (f32x4){0.f, 0.f, 0.f, 0.f};
#pragma unroll
            for (int ks = 0; ks < 8; ++ks) { const bf16x8 af = *(const LAS bf16x8*)(img + (16 * rt + fr) * S5_PITCH + 64 * ks + 16 * fq);
                yacc[rt][0] = MFMA16(w2f[0][ks], af, yacc[rt][0]); yacc[rt][1] = MFMA16(w2f[1][ks], af, yacc[rt][1]); }
        }
        lds_barrier();
#pragma unroll
        for (int rt = 0; rt < 4; ++rt) {
#pragma unroll
            for (int ks = 8; ks < 12; ++ks) { const bf16x8 af = *(const LAS bf16x8*)(img + (16 * rt + fr) * S5_PITCH + 64 * ks + 16 * fq);
                yacc[rt][0] = MFMA16(w2f[0][ks], af, yacc[rt][0]); yacc[rt][1] = MFMA16(w2f[1][ks], af, yacc[rt][1]); }
#pragma unroll
            for (int c2 = 0; c2 < 2; ++c2) { const f32x4 v = yacc[rt][c2]; u32x2 o; o.x = pk2(gelu_t(v[0]), gelu_t(v[1])); o.y = pk2(gelu_t(v[2]), gelu_t(v[3]));
                *(u32x2*)(G + (size_t)(b * SEQ + 16 * (64 * q + 16 * rt + fr) + 2 * wave + c2) * MW + g * 16 + 4 * fq) = o; }
        }
    }
}

constexpr int ATT_VP = 160;
__device__ __forceinline__ void stage_attn(const bf16* Qb, const bf16* Kb, const bf16* Vb, bf16* YS, LAS unsigned char* lds, int unit, int wave, int lane) {
    const int b = unit >> 7, hd = (unit >> 4) & 7, qb = unit & 15, t0 = 256 * qb + 32 * wave, r = lane & 31, hh = lane >> 5;
    const size_t hoff = (size_t)(b * 8 + hd) * SEQ * 128; const bf16* Qh = Qb + hoff; const bf16* Kh = Kb + hoff; const bf16* Vh = Vb + hoff;
    LAS bf16* Vs = (LAS bf16*)(lds + wave * (32 * ATT_VP * 2));
    bf16x8 qf[8], kf[8]; u32x4 vr[8];
#pragma unroll
    for (int ks = 0; ks < 8; ++ks) qf[ks] = *(const bf16x8*)(Qh + (size_t)(t0 + r) * 128 + 16 * ks + 8 * hh);
#define ATT_LOAD(S0) do { _Pragma("unroll") for (int ks = 0; ks < 8; ++ks) kf[ks] = *(const bf16x8*)(Kh + (size_t)((S0) + r) * 128 + 16 * ks + 8 * hh); \
        _Pragma("unroll") for (int i = 0; i < 8; ++i) vr[i] = *(const u32x4*)(Vh + (size_t)((S0) + (lane >> 4) + 4 * i) * 128 + 8 * (lane & 15)); } while (0)
    ATT_LOAD(t0);
    f32x16 o[4];
#pragma unroll
    for (int dt = 0; dt < 4; ++dt)
#pragma unroll
        for (int i = 0; i < 16; ++i) o[dt][i] = 0.f;
    float C = 1.f;
    const float c1 = 0.08838834764831845f * 1.4426950408889634f;
    const int trl = ((lane & 15) >> 2) * ATT_VP + 16 * ((lane >> 4) & 1) + 4 * (lane & 3);
    for (int s0 = t0;;) {
#pragma unroll
        for (int i = 0; i < 8; ++i) *(LAS u32x4*)(Vs + ((lane >> 4) + 4 * i) * ATT_VP + 8 * (lane & 15)) = vr[i];
        asm volatile("" ::: "memory");
        f32x16 z;
#pragma unroll
        for (int i = 0; i < 16; ++i) z[i] = 0.f;
#pragma unroll
        for (int ks = 0; ks < 8; ++ks) z = MFMA32(kf[ks], qf[ks], z);
        const int sn = s0 - 32;
        if (sn >= 0) ATT_LOAD(sn);
        float be[16], om[16], w[16];
#pragma unroll
        for (int i = 0; i < 16; ++i) { const float zr = z[i]; const float e = __builtin_amdgcn_exp2f(-fabsf(zr) * c1); const float rc = __builtin_amdgcn_rcpf(1.f + e), er = e * rc; const bool pos = zr > 0.f; be[i] = pos ? rc : er; om[i] = pos ? er : rc; }
        if (s0 == t0) {
#pragma unroll
            for (int i = 0; i < 16; ++i) { const bool valid = crow(i, hh) < r; be[i] = valid ? be[i] : 0.f; om[i] = valid ? om[i] : 1.f; }
        }
        float gp[4], pgp[4], aft[4];
#pragma unroll
        for (int gi = 0; gi < 4; ++gi) { w[4 * gi + 3] = 1.f; w[4 * gi + 2] = om[4 * gi + 3]; w[4 * gi + 1] = om[4 * gi + 2] * w[4 * gi + 2]; w[4 * gi] = om[4 * gi + 1] * w[4 * gi + 1]; gp[gi] = om[4 * gi] * w[4 * gi]; pgp[gi] = __shfl_xor(gp[gi], 32); }
        float run = 1.f;
#pragma unroll
        for (int gi = 3; gi >= 0; --gi) { aft[gi] = (hh ? run : run * pgp[gi]) * C; run *= gp[gi] * pgp[gi]; }
#pragma unroll
        for (int i = 0; i < 16; ++i) w[i] = be[i] * w[i] * aft[i >> 2];
        C *= run;
#pragma unroll
        for (int s = 0; s < 2; ++s) {
            u32x4 wp;
#pragma unroll
            for (int j = 0; j < 4; ++j) wp[j] = pk2(w[8 * s + 2 * j], w[8 * s + 2 * j + 1]);
            const bf16x8 wf = __builtin_bit_cast(bf16x8, wp);
#pragma unroll
            for (int dt = 0; dt < 4; ++dt) {
                const LAS bf16* vb = Vs + (16 * s + 4 * hh) * ATT_VP + 32 * dt + trl;
                const s16x4 lo = __builtin_amdgcn_ds_read_tr16_b64_v4i16((LAS s16x4*)vb), hi = __builtin_amdgcn_ds_read_tr16_b64_v4i16((LAS s16x4*)(vb + 8 * ATT_VP));
                o[dt] = MFMA32(__builtin_shufflevector(lo, hi, 0, 1, 2, 3, 4, 5, 6, 7), wf, o[dt]);
            }
        }
        if (sn < 0 || __all(C == 0.f)) break;
        s0 = sn;
    }
#undef ATT_LOAD
    bf16* orow = YS + (size_t)(b * SEQ + t0 + r) * YSW + 2 * MW + hd * 128;
#pragma unroll
    for (int dt = 0; dt < 4; ++dt)
#pragma unroll
        for (int gi = 0; gi < 4; ++gi) { u32x2 v; v.x = pk2(o[dt][4 * gi], o[dt][4 * gi + 1]); v.y = pk2(o[dt][4 * gi + 2], o[dt][4 * gi + 3]); *(u32x2*)(orow + 32 * dt + 8 * gi + 4 * hh) = v; }
}
#ifndef MK_DUP
#define MK_DUP -1
#endif
#define REP(k) for (int rep_ = 0; rep_ < ((MK_DUP) == (k) ? 2 : 1); ++rep_)
#ifndef STAG_NG
#define STAG_NG 1
#endif
#ifndef STAG_US
#define STAG_US 0
#endif
#define STAGGER() do { if (STAG_NG > 1) { const unsigned long long t0_ = __builtin_amdgcn_s_memrealtime(), dl_ = (unsigned long long)((bid >> 3) % STAG_NG) * (STAG_US) * 100ull; while (__builtin_amdgcn_s_memrealtime() - t0_ < dl_) __builtin_amdgcn_s_sleep(32); } } while (0)
#ifndef MK_SUB
#define MK_SUB 7
#endif
#ifndef MK_DIAG
#define MK_DIAG -1
#endif
#ifndef MK_DIAGV
#define MK_DIAGV 0
#endif
#ifndef MK_DIAGL
#define MK_DIAGL 0
#endif
#define DSTAMP(k, w) do { if (MK_DIAG == (k) && tid == 0) ((unsigned long long*)(ws + WS_SALL + 128 * MiB))[(w) * 256 + bid] = __builtin_amdgcn_s_memrealtime(); } while (0)
#define DSTAMPL(k, w) do { if (l == MK_DIAGL) DSTAMP(k, w); } while (0)
#ifndef MK_ONLY_PRO
#define MK_ONLY_PRO 1
#endif
#ifndef MK_ONLY_FIN
#define MK_ONLY_FIN 1
#endif
struct Args { const float* in[23]; float* out; unsigned char* ws; int l_lo, l_hi, ph_lo, ph_hi, pro, fin; };
constexpr int NPH = 10;
__global__ void __launch_bounds__(NTHR, 2) mk_fwd(Args a) {
    extern __shared__ __attribute__((aligned(16))) unsigned char lds_raw[];
    LAS unsigned char* lds = (LAS unsigned char*)lds_raw;
    const int wave_s = __builtin_amdgcn_readfirstlane(threadIdx.x >> 6);
    const int G = gridDim.x, ngw = G * NWAVES;
    unsigned char* ws = a.ws;
    for (int u = threadIdx.x; u < (LDS_BYTES - LDS_CTL_OFF) / 4; u += NTHR) ((LAS unsigned*)(lds + LDS_CTL_OFF))[u] = 0u;
    __syncthreads();
    XcdBarrier bar = xcd_barrier_post((unsigned*)(ws + WS_CTL), (volatile LAS unsigned*)(lds + LDS_CTL_OFF));
    float* X = (float*)(ws + WS_X); bf16* H = (bf16*)(ws + WS_H); bf16* P = (bf16*)(ws + WS_PROJ); unsigned char* pj = ws + WS_PROJ; bf16* Gb = (bf16*)(ws + WS_G); bf16* YS = (bf16*)(ws + WS_YS);
    bf16* MG = (bf16*)(ws + WS_MERGED); bf16* HID = (bf16*)(ws + WS_HID); float* VSQ = (float*)(ws + WS_VSQ); float* RSQa = (float*)(ws + WS_RSQ); float* RSQb = RSQa + (size_t)M * 32; bf16* SST = (bf16*)(ws + WS_SST);

#define LAUNDER() int lane_l, wave_l = wave_s, bid_l = blockIdx.x; asm volatile("v_mbcnt_lo_u32_b32 %0, -1, 0\n\tv_mbcnt_hi_u32_b32 %0, -1, %0" : "=v"(lane_l)); asm volatile("" : "+s"(wave_l), "+s"(bid_l)); const int lane = lane_l, wave = wave_l, bid = bid_l, tid = wave_l * 64 + lane_l, gw = bid_l * NWAVES + wave_l; (void)tid; (void)lane; (void)wave; (void)gw; (void)bid
    if ((MK_ONLY_PRO) && a.pro) REP(100) {
        LAUNDER();
        DSTAMP(3, 0); DSTAMP(4, 0);
        const ConvSrc cs{a.in[2], a.in[15], a.in[17], a.in[18], a.in[20], a.in[21], a.in[1], a.in[19]};
        if (G == 256) phase_conv(cs, ws, lds, gw, ngw, wave, lane, 0, CV_T_IN, CV_TL);
        else phase_conv(cs, ws, lds, gw, ngw, wave, lane, 0, CV_TL, 0);
        DSTAMP(4, 1); DSTAMP(5, 0);
        const S5Src ss{a.in[7], a.in[8], a.in[9], a.in[10], a.in[11], a.in[12], a.in[13], a.in[14]};
        phase_s5prep(ss, ws, lds, tid);
        DSTAMP(5, 1); DSTAMP(6, 0);
        phase_norm0(a.in[0], H, RSQb, gw, ngw, lane);
        DSTAMP(6, 1);
        xcd_barrier(bar, tid == 0);
        DSTAMP(3, 1);
    }
    for (int l = a.l_lo; l < a.l_hi; ++l) {
        unsigned char* wl = ws + WS_W + (size_t)l * WL_SIZE;
        const float* xsrc = (l == 0) ? a.in[0] : X;
#ifndef MK_ONLY
#define MK_ONLY -1
#endif
#ifndef MK_MASK
#define MK_MASK 0x3ff
#endif
#define IN(k) ((MK_ONLY < 0 || MK_ONLY == (k)) && ((MK_MASK >> (k)) & 1) && a.ph_lo <= (k) && (k) < a.ph_hi)
        if (IN(1)) REP(1) {
            LAUNDER();
            pg8::Gemm g{H, (const bf16*)(wl + WL_IN), M, PC, D}; pg8::StaticOrder S; S.init(M, PC, G, bid);
            LAS float* tab = (LAS float*)(lds + 131072); pg8::Unit u0; int pm0 = -1; if (S.next(0, u0)) { pm0 = u0.pm; rstd_table(RSQb, pm0, tab, tid); } __syncthreads();
            pg8::EpiProj E{P, a.in[3] + (size_t)l * 3 * D, VSQ, RSQb, tab, pm0};
            DSTAMPL(1, 0);
            const int cpos = (l == 0 && G == 256) ? ((bid & 7) < 6 ? (bid & 7) : 6) : -1;
#pragma unroll 1
            for (int part = 0; part < 2; ++part) {
                LAUNDER();
                if (part) {
                    if (cpos < 0) break;
                    const ConvSrc cs{a.in[2], a.in[15], a.in[17], a.in[18], a.in[20], a.in[21], a.in[1], a.in[19]};
                    DSTAMPL(2, 0);
                    phase_conv(cs, ws, lds, gw, ngw, wave, lane, CV_T_IN, CV_TL, CV_LATE);
                    DSTAMPL(2, 1);
                    __syncthreads(); if (pm0 >= 0) rstd_table(RSQb, pm0, tab, tid); __syncthreads();
                }
                pg8::SubOrder SS{S, part ? cpos : 0, (part || cpos < 0) ? (1 << 20) : cpos};
                pg8::gemm_phase<pg8::EpiProj, pg8::SubOrder, true, true>(lds, g, SS, E, tid);
            }
            { LAUNDER(); DSTAMPL(1, 1); }
            xcd_barrier(bar, tid == 0);
        }
        if (IN(2)) REP(2) {
            LAUNDER();
            const bool attn_first = (G == 256) && bid >= 128;
#define MIX_ATTN() do { if (MK_SUB & 4) REP(22) for (int u = bid; u < 256; u += G) stage_attn((const bf16*)(pj + PJ_Q), (const bf16*)(pj + PJ_K), (const bf16*)(pj + PJ_V), YS, lds, u, wave, lane); } while (0)
            if (attn_first) { lds_barrier(); MIX_ATTN(); lds_barrier(); }
            if (MK_SUB & 1) REP(20) for (int u = bid; u < 128; u += G) stage_s5((const bf16*)(pj + PJ_SIN), (const bf16*)(wl + WL_WST), (const bf16*)(wl + WL_W2), (const float2*)(wl + WL_A16), Gb, lds, u, tid, wave, lane);
            if (MK_SUB & 2) REP(21) {
                if (G == 256) { if (bid >= 128) stage_gmlp_units((const bf16*)(pj + PJ_U), (const bf16*)(pj + PJ_VG), VSQ, a.in[4] + (size_t)l * MW, a.in[5] + (size_t)l * 8 * 128 * 128, a.in[6] + (size_t)l * 8 * 128, YS, lds, bid - 128, 128, 512, tid, wave, lane); }
                else for (int g8 = 0; g8 < 8; ++g8) stage_gmlp_units((const bf16*)(pj + PJ_U), (const bf16*)(pj + PJ_VG), VSQ, a.in[4] + (size_t)l * MW, a.in[5] + (size_t)l * 8 * 128 * 128, a.in[6] + (size_t)l * 8 * 128, YS, lds, g8 + 8 * bid, 8 * G, 512, tid, wave, lane);
            }
            if (!attn_first) { lds_barrier(); MIX_ATTN(); }
#undef MIX_ATTN
            xcd_barrier(bar, tid == 0);
        }
        if (IN(4)) REP(4) {
            LAUNDER();
            pg8::Gemm g{Gb, (const bf16*)(wl + WL_GLU), M, MW, MW}; pg8::StaticOrder S; S.init(M, MW, G, bid);
            pg8::EpiGlu E{Gb, a.in[16] + (size_t)l * MW, YS};
            pg8::gemm_phase<pg8::EpiGlu, pg8::StaticOrder, true, true>(lds, g, S, E, tid);
            if (G == 256 && bid >= 128 && l + 1 < DEPTH) {
                const ConvSrc cs{a.in[2], a.in[15], a.in[17], a.in[18], a.in[20], a.in[21], a.in[1], a.in[19]};
                phase_conv_late(cs, ws, lds, l + 1, (bid - 128) * NWAVES + wave, 128 * NWAVES, wave, lane, CV_LATE);
            }
            xcd_barrier(bar, tid == 0);
        }
        if (IN(5)) REP(5) {
            LAUNDER();
            pg8::Gemm g{YS, (const bf16*)(wl + WL_BR), M, D, 3 * MW}; pg8::StaticOrder S; S.init(M, D, G, bid);
            pg8::EpiBranch E{(const bf16*)(pj + PJ_GT), MG};
            pg8::gemm_phase<pg8::EpiBranch, pg8::StaticOrder, true, true>(lds, g, S, E, tid);
            xcd_barrier(bar, tid == 0);
        }
        if (IN(6)) REP(6) {
            LAUNDER();
            pg8::Gemm g{MG, (const bf16*)(wl + WL_OUT), M, D, D}; pg8::StaticOrder S; S.init(M, D, G, bid);
            bf16* Hs = (bf16*)(ws + WS_SALL + 64 * MiB); float* Rs = (float*)(ws + WS_SALL + 96 * MiB);
            pg8::EpiResN E{l == 0 ? a.in[0] : nullptr, H, rep_ ? Hs : H, nullptr, rep_ ? Rs : RSQa};
            pg8::gemm_phase<pg8::EpiResN, pg8::StaticOrder, true, true>(lds, g, S, E, tid);
            xcd_barrier(bar, tid == 0);
        }
        if (IN(8)) REP(8) {
            LAUNDER();
            pg8::Gemm g{H, (const bf16*)(wl + WL_MI), M, DFF, D}; pg8::StaticOrder S; S.init(M, DFF, G, bid);
            LAS float* tab = (LAS float*)(lds + 131072); pg8::Unit u0; int pm0 = -1; if (S.next(0, u0)) { pm0 = u0.pm; rstd_table(RSQa, pm0, tab, tid); } __syncthreads();
            pg8::EpiRelu2 E{HID, RSQa, tab, pm0};
            STAGGER();
            pg8::gemm_phase<pg8::EpiRelu2, pg8::StaticOrder, true, true>(lds, g, S, E, tid);
            xcd_barrier(bar, tid == 0);
        }
        if (IN(9)) REP(9) {
            LAUNDER();
            pg8::Gemm g{HID, (const bf16*)(wl + WL_MO), M, D, DFF}; pg8::StaticOrder S; S.init(M, D, G, bid);
            bf16* Hs = (bf16*)(ws + WS_SALL + 64 * MiB); float* Rs = (float*)(ws + WS_SALL + 96 * MiB);
            pg8::EpiResN E{nullptr, H, rep_ ? Hs : H, (l == DEPTH - 1) ? X : nullptr, rep_ ? Rs : RSQb};
            pg8::gemm_phase<pg8::EpiResN, pg8::StaticOrder, true, true>(lds, g, S, E, tid);
            xcd_barrier(bar, tid == 0);
        }
#undef IN
    }
    if ((MK_ONLY_FIN) && a.fin) { LAUNDER(); phase_rmsnorm_f32(X, a.in[22], a.out, gw, ngw, lane);
        if (MK_DIAG >= 0) xcd_barrier(bar, tid == 0);
        if (MK_DIAG >= 0 && bid == 0 && tid == 0) {
            const unsigned long long* st = (const unsigned long long*)(ws + WS_SALL + 128 * MiB); unsigned long long mn0 = ~0ull, mx1 = 0; long long dmx = 0, dmn = 1ll << 60; double dsum = 0.0;
            const int i0 = (MK_DIAGV >= 10) ? (MK_DIAGV - 10) : 0, istep = (MK_DIAGV >= 10) ? 8 : 1; int cnt = 0;
            for (int i = i0; i < 256; i += istep) { const unsigned long long a0 = st[i], a1 = st[256 + i]; mn0 = a0 < mn0 ? a0 : mn0; mx1 = a1 > mx1 ? a1 : mx1; const long long d = (long long)(a1 - a0); dmx = d > dmx ? d : dmx; dmn = d < dmn ? d : dmn; dsum += (double)d; ++cnt; }
            const double v = (MK_DIAGV == 0) ? (double)(mx1 - mn0) : (MK_DIAGV == 7) ? (double)dmx : (MK_DIAGV == 8) ? (double)dmn : dsum / (double)cnt;
            volatile unsigned* sent = (volatile unsigned*)(ws + WS_SALL + 192 * MiB);
            double p10 = 1.0; while (v / p10 >= 100.0) p10 *= 10.0;
            const double q = (double)(long long)(v / p10 + 0.5) * p10;
            asm volatile("s_waitcnt vmcnt(0)" ::: "memory"); float e = (float)(q / p10); (void)q;
            if (sent[0] == 0x600DF00Du) e = __uint_as_float(sent[1]); else { sent[1] = __float_as_uint(e); sent[0] = 0x600DF00Du; }
            a.out[0] = e; }
    }
}
#ifndef MK_MODE
#define MK_MODE 0
#endif
static void mk_launch(const Args& a0, int grid, hipStream_t stream, int pro, int fin, int l_lo, int l_hi, int ph_lo, int ph_hi) {
    Args a = a0; a.pro = pro; a.fin = fin; a.l_lo = l_lo; a.l_hi = l_hi; a.ph_lo = ph_lo; a.ph_hi = ph_hi;
    hipMemsetAsync(a.ws + WS_CTL, 0, 16384, stream);
    hipLaunchKernelGGL(mk_fwd, dim3(grid), dim3(NTHR), LDS_BYTES, stream, a);
}
extern "C" void kernel_launch(void* const* d_in, const int* in_sizes, int n_in, void* d_out, int out_size, void* d_ws, size_t ws_size, hipStream_t stream) {
    static int grid = 0;
    if (grid == 0) {
        if (n_in != 23 || out_size != M * D || ws_size < WS_END) { fprintf(stderr, "kernel_launch: unexpected shapes (n_in %d out %d ws %zu need %zu)\n", n_in, out_size, ws_size, (size_t)WS_END); grid = -1; return; }
        int dev = 0, cus = 0, per_cu = 0;
        if (hipGetDevice(&dev) != hipSuccess || hipDeviceGetAttribute(&cus, hipDeviceAttributeMultiprocessorCount, dev) != hipSuccess) { grid = -1; return; }
        if (hipFuncSetAttribute((const void*)mk_fwd, hipFuncAttributeMaxDynamicSharedMemorySize, LDS_BYTES) != hipSuccess) { fprintf(stderr, "kernel_launch: hipFuncSetAttribute failed\n"); grid = -1; return; }
        if (hipOccupancyMaxActiveBlocksPerMultiprocessor(&per_cu, (const void*)mk_fwd, NTHR, LDS_BYTES) != hipSuccess || per_cu < 1) { fprintf(stderr, "kernel_launch: occupancy query says %d\n", per_cu); }
        (void)hipGetLastError();
        grid = cus;
    }
    if (grid < 0) return;
    Args a{};
    for (int i = 0; i < 23; ++i) a.in[i] = (const float*)d_in[i];
    a.out = (float*)d_out; a.ws = (unsigned char*)d_ws;
#if MK_MODE == 0
    mk_launch(a, grid, stream, 1, 1, 0, DEPTH, 0, NPH);
#else
    unsigned char* ws = (unsigned char*)d_ws;
    bf16* P = (bf16*)(ws + WS_PROJ); bf16* G = (bf16*)(ws + WS_G); bf16* YS = (bf16*)(ws + WS_YS); float* VRS = (float*)(ws + WS_VRS); float2* SALL = (float2*)(ws + WS_SALL);
    const float* gm_norm_g = a.in[4]; const float* gm_w_s = a.in[5]; const float* gm_b_s = a.in[6];
    const float* lre = a.in[7]; const float* lim = a.in[8]; const float* ldt = a.in[9]; const float* bre = a.in[10]; const float* bim = a.in[11]; const float* cre = a.in[12]; const float* cim = a.in[13]; const float* s5d = a.in[14];
    mk_launch(a, grid, stream, 1, 0, 0, 0, 0, 0);
    for (int l = 0; l < DEPTH; ++l) {
        mk_launch(a, grid, stream, 0, 0, l, l + 1, 0, 2);
        if (MK_SUB) mk_launch(a, grid, stream, 0, 0, l, l + 1, 2, 4);
        if (!(MK_SUB & 2)) {
            hipLaunchKernelGGL(k_vrstd, dim3(2048), dim3(256), 0, stream, (const bf16*)P, VRS);
            hipLaunchKernelGGL(k_ogmlp, dim3(64 * 8), dim3(256), 0, stream, (const bf16*)P, (const float*)VRS, gm_norm_g + (size_t)l * MW, gm_w_s + (size_t)l * 8 * 128 * 128, gm_b_s + (size_t)l * 8 * 128, YS);
        }
        if (!(MK_SUB & 1)) {
            hipLaunchKernelGGL(k_os5_scan, dim3(BATCH * 64), dim3(64), 0, stream, (const bf16*)P, lre + (size_t)l * 4096, lim + (size_t)l * 4096, ldt + (size_t)l * 64, bre + (size_t)l * 65536, bim + (size_t)l * 65536, SALL);
            hipLaunchKernelGGL(k_os5_out, dim3(M * MW / 256), dim3(256), 0, stream, (const bf16*)P, (const float2*)SALL, cre + (size_t)l * 65536, cim + (size_t)l * 65536, s5d + (size_t)l * MW, G);
        }
        if (!(MK_SUB & 4)) hipLaunchKernelGGL(k_oattn, dim3(BATCH * 8 * SEQ), dim3(64), 0, stream, (const bf16*)P, YS);
        mk_launch(a, grid, stream, 0, 0, l, l + 1, 4, NPH);
    }
    mk_launch(a, grid, stream, 0, 1, 0, 0, 0, 0);
#endif
}
```
